# Optimizing an MI355X kernel written in HIP

```python
import jax, jax.numpy as jnp
from jax import lax
import numpy as np


D_MODEL = 1024
BATCH = 16
SEQ = 2048
DEPTH = 4

N_MIXERS = 2
N_A = (DEPTH + 1) // 2
N_B = DEPTH // 2
EPS = 1e-6

A_HEADS = 4
A_DQK = D_MODEL // 8
A_DV = D_MODEL // 4
A_CHUNK = 64
A_TOK = 2 * A_HEADS * A_DQK + 2 * A_HEADS * A_DV + 2 * A_HEADS

B_HEADS = 16
B_KV_HEADS = 2
B_GROUP = B_HEADS // B_KV_HEADS
B_HD = D_MODEL // 16
B_WINDOW = 128
B_BLOCK = 128
B_TOK = (B_HEADS + 2 * B_KV_HEADS) * B_HD
ROT_DIM = B_HD // 4
ROPE_THETA = 500000.0

N_MEM = 256
M_HEADS = 4
M_HD = D_MODEL // 8
M_Q = M_HEADS * M_HD

A_IN = A_TOK + M_Q
B_IN = B_TOK + M_Q
A_OUT = A_HEADS * A_DV + M_Q
B_OUT = B_HEADS * B_HD + M_Q

D_FF = 256 * ((8 * D_MODEL // 3 + 255) // 256)

kernel_name = 'hybrid_mlstm_swa_sink_memxattn_macaron'


def rms_norm(x, g):
    xf = x.astype(jnp.float32)
    y = xf * lax.rsqrt(jnp.mean(xf * xf, axis=-1, keepdims=True) + EPS)
    return (y * g.astype(jnp.float32)).astype(x.dtype)


def swiglu(x, w_in, w_out):
    gate, up = jnp.split(x @ w_in, 2, axis=-1)
    return (jax.nn.silu(gate) * up) @ w_out


def rope_tables(positions):
    inv_freq = ROPE_THETA ** (-jnp.arange(0, ROT_DIM, 2, dtype=jnp.float32) / ROT_DIM)
    ang = positions.astype(jnp.float32)[..., None] * inv_freq
    return jnp.cos(ang), jnp.sin(ang)


def apply_partial_rope(x, cos, sin):
    half = ROT_DIM // 2
    x1, x2, rest = x[..., :half], x[..., half:ROT_DIM], x[..., ROT_DIM:]
    c, s = cos[:, :, None, :], sin[:, :, None, :]
    return jnp.concatenate([x1 * c - x2 * s, x2 * c + x1 * s, rest], axis=-1)


def mlstm_chunkwise(q, k, v, i_pre, logf):
    bsz, nh, t, dk = q.shape
    dv = v.shape[-1]
    nc = t // A_CHUNK

    def chunks(a):
        a = a.reshape(a.shape[:2] + (nc, A_CHUNK) + a.shape[3:])
        return jnp.moveaxis(a, 2, 0)

    causal = jnp.tril(jnp.ones((A_CHUNK, A_CHUNK), dtype=bool))

    def step(carry, inp):
        c_st, n_st, m_st = carry
        qc, kc, vc, ic, fc = inp
        b = jnp.cumsum(fc, axis=-1)
        log_d = b[..., :, None] - b[..., None, :] + ic[..., None, :]
        log_d = jnp.where(causal, log_d, -jnp.inf)
        m_inter = b + m_st[..., None]
        m_t = jnp.maximum(m_inter, jnp.max(log_d, axis=-1))
        s = jnp.einsum('bhjd,bhsd->bhjs', qc, kc) * jnp.exp(log_d - m_t[..., None])
        inter = jnp.exp(m_inter - m_t)
        num = (jnp.einsum('bhjs,bhsv->bhjv', s, vc)
               + inter[..., None] * jnp.einsum('bhjd,bhvd->bhjv', qc, c_st))
        den = jnp.sum(s, axis=-1) + inter * jnp.einsum('bhjd,bhd->bhj', qc, n_st)
        h = num / jnp.maximum(jnp.abs(den), jnp.exp(-m_t))[..., None]
        b_last = b[..., -1]
        log_w = b_last[..., None] - b + ic
        m_new = jnp.maximum(b_last + m_st, jnp.max(log_w, axis=-1))
        w = jnp.exp(log_w - m_new[..., None])
        decay = jnp.exp(b_last + m_st - m_new)
        c_new = decay[..., None, None] * c_st + jnp.einsum('bhsv,bhsd->bhvd', w[..., None] * vc, kc)
        n_new = decay[..., None] * n_st + jnp.einsum('bhs,bhsd->bhd', w, kc)
        return (c_new, n_new, m_new), h

    init = (jnp.zeros((bsz, nh, dv, dk), jnp.float32),
            jnp.zeros((bsz, nh, dk), jnp.float32),
            jnp.zeros((bsz, nh), jnp.float32))
    xs = (chunks(q * dk ** -0.5), chunks(k), chunks(v), chunks(i_pre), chunks(logf))
    _, hs = lax.scan(step, init, xs)
    return jnp.moveaxis(hs, 0, 2).reshape(bsz, nh, t, dv)


def mlstm_heads(tok, gate_b, h_norm_g):
    bsz, t, _ = tok.shape
    o1 = A_HEADS * A_DQK
    o2 = 2 * o1
    o3 = o2 + A_HEADS * A_DV
    o4 = o3 + A_HEADS * A_DV
    f32 = jnp.float32
    q = tok[..., :o1].reshape(bsz, t, A_HEADS, A_DQK).transpose(0, 2, 1, 3).astype(f32)
    k = tok[..., o1:o2].reshape(bsz, t, A_HEADS, A_DQK).transpose(0, 2, 1, 3).astype(f32)
    v = tok[..., o2:o3].reshape(bsz, t, A_HEADS, A_DV).transpose(0, 2, 1, 3).astype(f32)
    o_gate = jax.nn.sigmoid(tok[..., o3:o4].astype(f32))
    gates = tok[..., o4:].astype(f32) + gate_b.astype(f32)
    i_pre = gates[..., :A_HEADS].transpose(0, 2, 1)
    logf = jax.nn.log_sigmoid(gates[..., A_HEADS:]).transpose(0, 2, 1)
    h = mlstm_chunkwise(q, k, v, i_pre, logf).transpose(0, 2, 1, 3)
    h = rms_norm(h, h_norm_g.reshape(A_HEADS, A_DV)).reshape(bsz, t, A_HEADS * A_DV)
    return (h * o_gate).astype(tok.dtype)


def swa_heads(tok, cos, sin, q_norm_g, k_norm_g, sinks):
    bsz, t, _ = tok.shape
    f32 = jnp.float32
    nq = B_HEADS * B_HD
    nk = B_KV_HEADS * B_HD
    q = tok[..., :nq].reshape(bsz, t, B_HEADS, B_HD).astype(f32)
    k = tok[..., nq:nq + nk].reshape(bsz, t, B_KV_HEADS, B_HD).astype(f32)
    v = tok[..., nq + nk:].reshape(bsz, t, B_KV_HEADS, B_HD).astype(f32)
    q = apply_partial_rope(rms_norm(q, q_norm_g), cos, sin) * B_HD ** -0.5
    k = apply_partial_rope(rms_norm(k, k_norm_g), cos, sin)
    nb = t // B_BLOCK
    qb = q.reshape(bsz, nb, B_BLOCK, B_KV_HEADS, B_GROUP, B_HD)
    kb = k.reshape(bsz, nb, B_BLOCK, B_KV_HEADS, B_HD)
    vb = v.reshape(bsz, nb, B_BLOCK, B_KV_HEADS, B_HD)

    def band(a):
        prev = jnp.concatenate([jnp.zeros_like(a[:, :1]), a[:, :-1]], axis=1)
        return jnp.moveaxis(jnp.concatenate([prev, a], axis=2), 1, 0)

    qi = jnp.arange(B_BLOCK)[:, None]
    kj = jnp.arange(2 * B_BLOCK)[None, :]
    diff = B_BLOCK + qi - kj
    in_window = (diff >= 0) & (diff < B_WINDOW)
    sink = sinks.astype(f32).reshape(B_KV_HEADS, B_GROUP)[None, :, :, None, None]

    def block(args):
        n, qn, kn, vn = args
        valid = in_window & ((n * B_BLOCK - B_BLOCK + kj) >= 0)
        s = jnp.einsum('bqhgd,bkhd->bhgqk', qn, kn)
        s = jnp.where(valid, s, -jnp.inf)
        m = jnp.maximum(jnp.max(s, axis=-1, keepdims=True), sink)
        p = jnp.exp(s - m)
        denom = jnp.sum(p, axis=-1, keepdims=True) + jnp.exp(sink - m)
        return jnp.einsum('bhgqk,bkhd->bqhgd', p / denom, vn)

    out = lax.map(block, (jnp.arange(nb), jnp.moveaxis(qb, 1, 0), band(kb), band(vb)))
    return jnp.moveaxis(out, 0, 1).reshape(bsz, t, nq).astype(tok.dtype)


def memory_heads(xq, mem_k, mem_v, q_norm_g, k_norm_g):
    bsz, t, _ = xq.shape
    f32 = jnp.float32
    q = rms_norm(xq.reshape(bsz, t, M_HEADS, M_HD).astype(f32), q_norm_g)
    k = rms_norm(mem_k.astype(f32), k_norm_g)
    s = jnp.einsum('bthd,bmhd->bhtm', q, k) * M_HD ** -0.5
    p = jax.nn.softmax(s, axis=-1)
    o = jnp.einsum('bhtm,bmhd->bthd', p, mem_v.astype(f32))
    return o.reshape(bsz, t, M_Q).astype(xq.dtype)


def setup_inputs(seed: int = 0) -> dict:
    key = jax.random.key(seed)
    ks = jax.random.split(key, 32)
    f32 = jnp.float32

    def normal(k, shape, scale):
        return jax.random.normal(k, shape, f32) * scale

    def gain(k, shape):
        return 1.0 + 0.05 * jax.random.normal(k, shape, f32)

    x = normal(ks[0], (BATCH, SEQ, D_MODEL), 1.0)
    mem = normal(ks[1], (BATCH, N_MEM, D_MODEL), 1.0)
    start = jax.random.randint(ks[2], (BATCH, 1), 0, 4096, dtype=jnp.int32)
    positions = start + jnp.arange(SEQ, dtype=jnp.int32)[None, :]
    i_bias = normal(ks[3], (N_A, A_HEADS), 0.1)
    f_bias = jnp.linspace(3.0, 6.0, A_HEADS, dtype=f32)[None, :] + normal(ks[4], (N_A, A_HEADS), 0.1)
    return {
        'x': x,
        'mem': mem,
        'positions': positions,
        'mem_norm_g': gain(ks[5], (D_MODEL,)),
        'mem_w_kv': normal(ks[6], (D_MODEL, 2 * M_Q), D_MODEL ** -0.5),
        'ffn1_norm_g': gain(ks[7], (DEPTH, D_MODEL)),
        'ffn1_w_in': normal(ks[8], (DEPTH, D_MODEL, 2 * D_FF), D_MODEL ** -0.5),
        'ffn1_w_out': normal(ks[9], (DEPTH, D_FF, D_MODEL), 0.5 * D_FF ** -0.5),
        'mix_norm_g': gain(ks[10], (DEPTH, D_MODEL)),
        'ffn2_norm_g': gain(ks[11], (DEPTH, D_MODEL)),
        'ffn2_w_in': normal(ks[12], (DEPTH, D_MODEL, 2 * D_FF), D_MODEL ** -0.5),
        'ffn2_w_out': normal(ks[13], (DEPTH, D_FF, D_MODEL), 0.5 * D_FF ** -0.5),
        'xa_q_norm_g': gain(ks[14], (DEPTH, M_HD)),
        'xa_k_norm_g': gain(ks[15], (DEPTH, M_HD)),
        'a_w_in': normal(ks[16], (N_A, D_MODEL, A_IN), D_MODEL ** -0.5),
        'a_gate_b': jnp.concatenate([i_bias, f_bias], axis=-1),
        'a_h_norm_g': gain(ks[17], (N_A, A_HEADS * A_DV)),
        'a_w_out': normal(ks[18], (N_A, A_OUT, D_MODEL), 0.5 * A_OUT ** -0.5),
        'b_w_in': normal(ks[19], (N_B, D_MODEL, B_IN), D_MODEL ** -0.5),
        'b_q_norm_g': gain(ks[20], (N_B, B_HD)),
        'b_k_norm_g': gain(ks[21], (N_B, B_HD)),
        'b_sinks': normal(ks[22], (N_B, B_HEADS), 0.5),
        'b_w_out': normal(ks[23], (N_B, B_OUT, D_MODEL), 0.5 * B_OUT ** -0.5),
    }


def reference(x, mem, positions, mem_norm_g, mem_w_kv, ffn1_norm_g, ffn1_w_in, ffn1_w_out,
              mix_norm_g, ffn2_norm_g, ffn2_w_in, ffn2_w_out, xa_q_norm_g, xa_k_norm_g,
              a_w_in, a_gate_b, a_h_norm_g, a_w_out,
              b_w_in, b_q_norm_g, b_k_norm_g, b_sinks, b_w_out):
    bsz, n_mem, _ = mem.shape
    mem_kv = rms_norm(mem, mem_norm_g) @ mem_w_kv
    mem_k = mem_kv[..., :M_Q].reshape(bsz, n_mem, M_HEADS, M_HD)
    mem_v = mem_kv[..., M_Q:].reshape(bsz, n_mem, M_HEADS, M_HD)
    cos, sin = rope_tables(positions)
    for i in range(DEPTH):
        j = i // N_MIXERS
        x = x + 0.5 * swiglu(rms_norm(x, ffn1_norm_g[i]), ffn1_w_in[i], ffn1_w_out[i])
        hn = rms_norm(x, mix_norm_g[i])
        if i % N_MIXERS == 0:
            proj = hn @ a_w_in[j]
            y_tok = mlstm_heads(proj[..., :A_TOK], a_gate_b[j], a_h_norm_g[j])
            xq = proj[..., A_TOK:]
            w_out = a_w_out[j]
        else:
            proj = hn @ b_w_in[j]
            y_tok = swa_heads(proj[..., :B_TOK], cos, sin, b_q_norm_g[j], b_k_norm_g[j], b_sinks[j])
            xq = proj[..., B_TOK:]
            w_out = b_w_out[j]
        y_mem = memory_heads(xq, mem_k, mem_v, xa_q_norm_g[i], xa_k_norm_g[i])
        x = x + jnp.concatenate([y_tok, y_mem], axis=-1) @ w_out
        x = x + 0.5 * swiglu(rms_norm(x, ffn2_norm_g[i]), ffn2_w_in[i], ffn2_w_out[i])
    return x
```

```cpp
#include <hip/hip_runtime.h>
#include <hip/hip_cooperative_groups.h>
#include <cstdio>
#include <cmath>
namespace cg = cooperative_groups;

#define LAS __attribute__((address_space(3)))
#define GAS __attribute__((address_space(1)))
typedef unsigned short bf16_t;
typedef short bf16x8 __attribute__((ext_vector_type(8)));
typedef short bf16x4 __attribute__((ext_vector_type(4)));
typedef float f32x4 __attribute__((ext_vector_type(4)));
typedef unsigned u32x4 __attribute__((ext_vector_type(4)));
typedef unsigned u32x2 __attribute__((ext_vector_type(2)));

constexpr int DM = 1024, NB = 16, SEQ = 2048, MTOK = NB * SEQ, DFF = 2816, DEPTH = 4;
constexpr int A_INW = 3592, A_NPAD = 3840, A_LDP = 3584, B_INW = 1792, OUTK = 1536;
constexpr int NMEM = 256, MROWS = NB * NMEM;
constexpr float EPS = 1e-6f;
constexpr int NTHREADS = 512;
constexpr int LDS_BYTES = 148 * 1024;
constexpr int XCD_BAR_WORDS_C = 3456;
#ifndef SPL
#define SPL 8
#define STEP_TABLE 0x76543210ull
#endif

constexpr size_t al256(size_t x) { return (x + 255) & ~(size_t)255; }
constexpr size_t WS_WIN0 = 0;
constexpr size_t WS_WIN1 = WS_WIN0 + al256((size_t)2 * DFF * DM * 2);
constexpr size_t WS_WOUT0 = WS_WIN1 + al256((size_t)2 * DFF * DM * 2);
constexpr size_t WS_WOUT1 = WS_WOUT0 + al256((size_t)DM * DFF * 2);
constexpr size_t WS_MIN = WS_WOUT1 + al256((size_t)DM * DFF * 2);
constexpr size_t WS_MOUT = WS_MIN + al256((size_t)A_NPAD * DM * 2);
constexpr size_t WS_WG = WS_MOUT + al256((size_t)DM * OUTK * 2);
constexpr size_t WS_MEMW = WS_WG + al256((size_t)16 * DM * 2);
constexpr size_t WS_MEMB = WS_MEMW + al256((size_t)1024 * DM * 2);
constexpr size_t WS_MEMK = WS_MEMB + al256((size_t)MROWS * DM * 2);
constexpr size_t WS_MEMVT = WS_MEMK + al256((size_t)MROWS * 512 * 2);
constexpr size_t WS_MEMRS = WS_MEMVT + al256((size_t)MROWS * 512 * 2);
constexpr size_t WS_XB = WS_MEMRS + al256((size_t)MROWS * 4);
constexpr size_t WS_H = WS_XB + al256((size_t)MTOK * DM * 2);
constexpr size_t WS_Y = WS_H + al256((size_t)MTOK * A_LDP * 2);
constexpr size_t WS_GATES = WS_Y + al256((size_t)MTOK * OUTK * 2);
constexpr size_t WS_RSS = WS_GATES + al256((size_t)MTOK * 8 * 4);
constexpr size_t WS_ROPE = WS_RSS + al256((size_t)16 * MTOK * 4);
constexpr size_t WS_BAR = WS_ROPE + al256((size_t)MTOK * 16 * 4);
constexpr size_t WS_SET1 = WS_BAR + al256((size_t)XCD_BAR_WORDS_C * 4);
constexpr size_t WS_END = WS_SET1 + WS_MEMW;

struct Params {
    const float* in[23];
    float* out;
    unsigned char* ws;
    int ph_lo, ph_hi;
};

typedef float f32x2 __attribute__((ext_vector_type(2)));
typedef __bf16 bf16x2_t __attribute__((ext_vector_type(2)));
__device__ __forceinline__ unsigned cvt_pk_bf16(float lo, float hi) { const f32x2 v = {lo, hi}; return __builtin_bit_cast(unsigned, __builtin_convertvector(v, bf16x2_t)); }
__device__ __forceinline__ unsigned cvt_pk_bf16(f32x2 v) { return __builtin_bit_cast(unsigned, __builtin_convertvector(v, bf16x2_t)); }
__device__ __forceinline__ float bf2f(unsigned short h) { return __uint_as_float(((unsigned)h) << 16); }
__device__ __forceinline__ float bflo(unsigned w) { return __uint_as_float(w << 16); }
__device__ __forceinline__ float bfhi(unsigned w) { return __uint_as_float(w & 0xffff0000u); }
__device__ __forceinline__ f32x4 mfma16(bf16x8 a, bf16x8 b, f32x4 c) { return __builtin_amdgcn_mfma_f32_16x16x32_bf16(a, b, c, 0, 0, 0); }
__device__ __forceinline__ bf16x8 pack8(f32x4 a, f32x4 b) {
    u32x4 t; t.x = cvt_pk_bf16(a[0], a[1]); t.y = cvt_pk_bf16(a[2], a[3]); t.z = cvt_pk_bf16(b[0], b[1]); t.w = cvt_pk_bf16(b[2], b[3]);
    return __builtin_bit_cast(bf16x8, t);
}
__device__ __forceinline__ bf16x8 lds8(const LAS bf16_t* base, int ld, int row, int col) { return *(const LAS bf16x8*)(base + row * ld + col); }
__device__ __forceinline__ bf16x8 lds4x2(const LAS bf16_t* base, int ld, int row, int col) {
    const u32x2 a = *(const LAS u32x2*)(base + row * ld + col), b = *(const LAS u32x2*)(base + row * ld + col + 16);
    u32x4 t; t.x = a.x; t.y = a.y; t.z = b.x; t.w = b.y; return __builtin_bit_cast(bf16x8, t);
}
__device__ __forceinline__ float xsum16(float v) { const auto r = __builtin_amdgcn_permlane16_swap(__float_as_uint(v), __float_as_uint(v), false, false); return __uint_as_float(r[0]) + __uint_as_float(r[1]); }
__device__ __forceinline__ float xsum32(float v) { const auto r = __builtin_amdgcn_permlane32_swap(__float_as_uint(v), __float_as_uint(v), false, false); return __uint_as_float(r[0]) + __uint_as_float(r[1]); }
__device__ __forceinline__ float xmax16(float v) { const auto r = __builtin_amdgcn_permlane16_swap(__float_as_uint(v), __float_as_uint(v), false, false); return fmaxf(__uint_as_float(r[0]), __uint_as_float(r[1])); }
__device__ __forceinline__ float xmax32(float v) { const auto r = __builtin_amdgcn_permlane32_swap(__float_as_uint(v), __float_as_uint(v), false, false); return fmaxf(__uint_as_float(r[0]), __uint_as_float(r[1])); }
__device__ __forceinline__ float shfl_from(float v, int srclane) { return __int_as_float(__builtin_amdgcn_ds_bpermute(srclane << 2, __float_as_int(v))); }
__device__ __forceinline__ float dpp_x1(float v) { return __int_as_float(__builtin_amdgcn_update_dpp(0, __float_as_int(v), 0xB1, 0xf, 0xf, true)); }
__device__ __forceinline__ float rowsum4(float v) { v += dpp_x1(v); v += __int_as_float(__builtin_amdgcn_update_dpp(0, __float_as_int(v), 0x4E, 0xf, 0xf, true)); return v; }
__device__ __forceinline__ float rowsum8(float v) { v = rowsum4(v); v += __int_as_float(__builtin_amdgcn_update_dpp(0, __float_as_int(v), 0x141, 0xf, 0xf, true)); return v; }
__device__ __forceinline__ float rowsum16(float v) { v = rowsum8(v); v += __int_as_float(__builtin_amdgcn_update_dpp(0, __float_as_int(v), 0x140, 0xf, 0xf, true)); return v; }
__device__ __forceinline__ float wave_sum(float v) {
    v = rowsum16(v); v = xsum16(v); v = xsum32(v);
    return v;
}
__device__ __forceinline__ float fast_exp(float x) { return __builtin_amdgcn_exp2f(x * 1.44269504088896341f); }
__device__ __forceinline__ float sigmoidf_(float x) { return __builtin_amdgcn_rcpf(1.0f + fast_exp(-x)); }
__device__ __forceinline__ int perm32(int rho) { const int n = rho >> 4, i = rho & 15; return 8 * (i >> 2) + 4 * n + (i & 3); }

constexpr int LDS_PTRS = LDS_BYTES - 304;
__device__ __forceinline__ const float* ld_inptr(LAS unsigned char* lds, int k) {
    const u32x2 v = *(const LAS u32x2*)(lds + LDS_PTRS + 8 * k);
    const unsigned lo = __builtin_amdgcn_readfirstlane(v.x), hi = __builtin_amdgcn_readfirstlane(v.y);
    return (const float*)(((unsigned long long)hi << 32) | (unsigned long long)lo);
}
#define INP(k) ld_inptr(lds, k)
namespace pg8 {
constexpr int BM = 256, BK = 64, HALF = 128, HTB = HALF * BK * 2, STAGE_BYTES = 8 * HTB, NXCD = 8, WGM = 8;
__device__ __forceinline__ int lds_byte(int r, int c) { const int st = (r >> 4) * 2 + (c >> 5), rr = r & 15, cc = c & 31, ob = rr * 64 + cc * 2; return st * 1024 + (ob ^ (((ob >> 9) & 1) << 5)); }
__device__ __forceinline__ void stage_rc(int b, int& R, int& C) { const int st = b / 1024, sb = b % 1024, swz = sb ^ (((sb >> 9) & 1) << 5); R = (st >> 1) * 16 + swz / 64; C = (st & 1) * 32 + (swz % 64) / 2; }
struct Unit { int pm, pn; };
struct Gemm { const bf16_t* A; const bf16_t* Bt; int M, N, K; };
struct StaticOrder {
    int nM, nN, nwg, G, c;
    __device__ void init(int M, int N, int G_, int c_) { nM = M / BM; nN = N / BM; nwg = nM * nN; G = G_; c = c_; }
    __device__ bool next(int i, Unit& u) const {
        const long L = (long)i * G + c; if (L >= nwg) return false;
        int wgid = (int)L; { const int q = nwg / NXCD, r = nwg % NXCD, xcd = wgid % NXCD, off = wgid / NXCD; wgid = (xcd < r ? xcd * (q + 1) : r * (q + 1) + (xcd - r) * q) + off; }
        const int nig = WGM * nN, gid = wgid / nig, fm = gid * WGM, gsz = (nM - fm) < WGM ? (nM - fm) : WGM;
        u.pm = fm + ((wgid % nig) % gsz); u.pn = (wgid % nig) / gsz; return true;
    }
};

__device__ __forceinline__ void row_rs8(const float* rss, int row0, int fq, float (&rsv)[2][4]) {
    float ps[2][4];
#pragma unroll
    for (int ai = 0; ai < 2; ++ai)
#pragma unroll
        for (int m = 0; m < 4; ++m) {
            const f32x4 q = *(const f32x4*)(rss + (size_t)(row0 + ai * HALF + m * 16) * 16 + 4 * fq);
            ps[ai][m] = (q[0] + q[1]) + (q[2] + q[3]);
        }
#pragma unroll
    for (int ai = 0; ai < 2; ++ai)
#pragma unroll
        for (int m = 0; m < 4; ++m) {
            float s = ps[ai][m];
            s = xsum16(s); s = xsum32(s);
            rsv[ai][m] = 1.0f / sqrtf(s * (1.0f / 1024.0f) + EPS);
        }
}

constexpr int RS2_OFF = STAGE_BYTES + 16384;
__device__ __forceinline__ void rs_finalize(LAS unsigned char* lds, int wid) {
    if (wid < 4) {
        int l2; asm volatile("v_mbcnt_lo_u32_b32 %0, -1, 0\n\tv_mbcnt_hi_u32_b32 %0, -1, %0" : "=v"(l2));
        const int row = wid * 64 + l2;
        const LAS f32x4* q = (const LAS f32x4*)(lds + STAGE_BYTES) + row * 4;
        const f32x4 t = (q[0] + q[1]) + (q[2] + q[3]);
        const float rs = __builtin_amdgcn_rsqf(((t[0] + t[1]) + (t[2] + t[3])) * (1.0f / 1024.0f) + EPS);
        f32x2 o; o.x = rs; o.y = rs * rs;
        *(LAS f32x2*)(lds + RS2_OFF + row * 8) = o;
    }
}
__device__ __forceinline__ f32x2 rs_entry(LAS unsigned char* lds, int lrow) { return *(const LAS f32x2*)(lds + RS2_OFF + lrow * 8); }

struct EpiSwiglu {
    static constexpr bool RS_LDS = true, EARLY = true;
    const float* rss; bf16_t* H;
    static __device__ __forceinline__ f32x2 act2(f32x2 g, f32x2 up, float nrs, float rs2) {
        const f32x2 t = g * nrs;
        f32x2 d; d.x = __builtin_amdgcn_exp2f(t.x); d.y = __builtin_amdgcn_exp2f(t.y);
        d = d + 1.0f;
        f32x2 r; r.x = __builtin_amdgcn_rcpf(d.x); r.y = __builtin_amdgcn_rcpf(d.y);
        return ((g * up) * rs2) * r;
    }
    __device__ __forceinline__ void early_rs(int wr, LAS unsigned char* lds, int m, float (&er)[2]) const {
        int l2; asm volatile("v_mbcnt_lo_u32_b32 %0, -1, 0\n\tv_mbcnt_hi_u32_b32 %0, -1, %0" : "=v"(l2));
        const f32x2 e = rs_entry(lds, wr * 64 + m * 16 + (l2 & 15));
        er[0] = e.x * -1.44269504088896341f; er[1] = e.y;
    }
    __device__ __forceinline__ void early_pair(f32x4 (&acc)[2][2][4][2], int m, int j, const float (&er)[2]) const {
        const int n = (j >> 1) & 1, hp = j & 1;
        const f32x2 g = {acc[0][0][m][n][2 * hp], acc[0][0][m][n][2 * hp + 1]}, up = {acc[0][1][m][n][2 * hp], acc[0][1][m][n][2 * hp + 1]};
        const f32x2 hh = act2(g, up, er[0], er[1]);
        acc[0][0][m][n][2 * hp] = hh.x; acc[0][0][m][n][2 * hp + 1] = hh.y;
    }
    __device__ __forceinline__ void operator()(f32x4 (&acc)[2][2][4][2], const Unit& u, int wr, int wc, int fr, int fq, LAS unsigned char* lds) const {
        const int row0 = u.pm * BM + wr * 64 + fr, j0 = u.pn * 128 + wc * 32 + fq * 8;
#pragma unroll
        for (int m = 0; m < 4; ++m) {
            u32x4 wv; wv.x = cvt_pk_bf16(acc[0][0][m][0][0], acc[0][0][m][0][1]); wv.y = cvt_pk_bf16(acc[0][0][m][0][2], acc[0][0][m][0][3]);
            wv.z = cvt_pk_bf16(acc[0][0][m][1][0], acc[0][0][m][1][1]); wv.w = cvt_pk_bf16(acc[0][0][m][1][2], acc[0][0][m][1][3]);
            *(u32x4*)(H + (size_t)(row0 + m * 16) * DFF + j0) = wv;
        }
#pragma unroll
        for (int m = 0; m < 4; ++m) {
            const int row = row0 + HALF + m * 16;
            const f32x2 e_ = rs_entry(lds, HALF + wr * 64 + m * 16 + fr);
            const float nrs = e_.x * -1.44269504088896341f, rs2 = e_.y;
            unsigned w[4];
#pragma unroll
            for (int n = 0; n < 2; ++n)
#pragma unroll
                for (int hp = 0; hp < 2; ++hp) {
                    const f32x2 g = {acc[1][0][m][n][2 * hp], acc[1][0][m][n][2 * hp + 1]}, up = {acc[1][1][m][n][2 * hp], acc[1][1][m][n][2 * hp + 1]};
                    w[2 * n + hp] = cvt_pk_bf16(act2(g, up, nrs, rs2));
                }
            u32x4 wv; wv.x = w[0]; wv.y = w[1]; wv.z = w[2]; wv.w = w[3];
            *(u32x4*)(H + (size_t)row * DFF + j0) = wv;
        }
    }
};
__device__ __forceinline__ f32x2 xdec2(unsigned w, float b0, float b1) {
    const unsigned h0 = w << 16, h1 = w & 0xffff0000u;
    const float u0 = __uint_as_float(h0 & 0x7f800000u), u1 = __uint_as_float(h1 & 0x7f800000u);
    f32x2 r;
    r.x = fmaf(fmaf(b0, 0x1p-15f, -0x1p-8f), u0, __uint_as_float(h0));
    r.y = fmaf(fmaf(b1, 0x1p-15f, -0x1p-8f), u1, __uint_as_float(h1));
    return r;
}
__device__ __forceinline__ unsigned xenc2(float x0, float x1, unsigned& w) {
    w = cvt_pk_bf16(x0, x1);
    const unsigned h0 = w << 16, h1 = w & 0xffff0000u;
    const unsigned s0 = 0x86800000u - (h0 & 0x7f800000u), s1 = 0x86800000u - (h1 & 0x7f800000u);
    const float q0 = fmaf(x0 - __uint_as_float(h0), __uint_as_float(s0 < 0x7f000000u ? s0 : 0x7f000000u), 128.5f);
    const float q1 = fmaf(x1 - __uint_as_float(h1), __uint_as_float(s1 < 0x7f000000u ? s1 : 0x7f000000u), 128.5f);
    unsigned r = __builtin_amdgcn_cvt_pk_u8_f32(q0, 0u, 0u);
    r = __builtin_amdgcn_cvt_pk_u8_f32(q1, 1u, r);
    return r;
}
struct EpiResid {
    static constexpr bool RS_LDS = false, EARLY = false;
    __device__ __forceinline__ void early_rs(int, LAS unsigned char*, int, float (&)[2]) const {}
    __device__ __forceinline__ void early_pair(f32x4 (&)[2][2][4][2], int, int, const float (&)[2]) const {}
    float* xout_f32; bf16_t* xb; unsigned char* xlo; float* rss;
    __device__ __forceinline__ void operator()(f32x4 (&acc)[2][2][4][2], const Unit& u, int wr, int wc, int fr, int fq, LAS unsigned char* lds) const {
        const int row0 = u.pm * BM + wr * 64 + fr, c0 = u.pn * BM + wc * 32 + fq * 8;
        const unsigned e0 = (unsigned)(row0 * DM + c0);
        {
#pragma unroll
            for (int ai = 0; ai < 2; ++ai)
#pragma unroll
                for (int mh = 0; mh < 2; ++mh) {
                    u32x4 hh[2][2]; u32x2 ll[2][2];
#pragma unroll
                    for (int m = 0; m < 2; ++m)
#pragma unroll
                        for (int bj = 0; bj < 2; ++bj) {
                            const unsigned off = e0 + (unsigned)((ai * HALF + (2 * mh + m) * 16) * DM + bj * HALF);
                            hh[m][bj] = *(const GAS u32x4*)((const GAS char*)xb + 2u * off); ll[m][bj] = *(const GAS u32x2*)((const GAS char*)xlo + off);
                        }
#pragma unroll
                    for (int m = 0; m < 2; ++m)
#pragma unroll
                        for (int bj = 0; bj < 2; ++bj) {
                            const u32x4 hw = hh[m][bj]; const u32x2 lw = ll[m][bj];
                            const f32x2 d0 = xdec2(hw.x, (float)(lw.x & 0xffu), (float)((lw.x >> 8) & 0xffu)), d1 = xdec2(hw.y, (float)((lw.x >> 16) & 0xffu), (float)(lw.x >> 24));
                            const f32x2 d2 = xdec2(hw.z, (float)(lw.y & 0xffu), (float)((lw.y >> 8) & 0xffu)), d3 = xdec2(hw.w, (float)((lw.y >> 16) & 0xffu), (float)(lw.y >> 24));
                            acc[ai][bj][2 * mh + m][0] += (f32x4){d0.x, d0.y, d1.x, d1.y}; acc[ai][bj][2 * mh + m][1] += (f32x4){d2.x, d2.y, d3.x, d3.y};
                        }
                    __builtin_amdgcn_sched_barrier(0);
                }
        }
        unsigned e1 = e0; asm volatile("" : "+v"(e1));
#pragma unroll
        for (int ai = 0; ai < 2; ++ai)
#pragma unroll
            for (int m = 0; m < 4; ++m) {
                const int row = row0 + ai * HALF + m * 16; float ss = 0.f;
#pragma unroll
                for (int bj = 0; bj < 2; ++bj) {
                    const unsigned off = e1 + (unsigned)((ai * HALF + m * 16) * DM + bj * HALF);
                    const f32x4 o0 = acc[ai][bj][m][0], o1 = acc[ai][bj][m][1];
                    u32x4 hw; u32x2 lw;
                    { unsigned w0_, w1_, w2_, w3_;
                      const unsigned c0_ = xenc2(o0[0], o0[1], w0_), c1_ = xenc2(o0[2], o0[3], w1_), c2_ = xenc2(o1[0], o1[1], w2_), c3_ = xenc2(o1[2], o1[3], w3_);
                      hw.x = w0_; hw.y = w1_; hw.z = w2_; hw.w = w3_; lw.x = c0_ | (c1_ << 16); lw.y = c2_ | (c3_ << 16); }
                    *(GAS u32x4*)((GAS char*)xb + 2u * off) = hw; *(GAS u32x2*)((GAS char*)xlo + off) = lw;
                    if (xout_f32) { *(GAS f32x4*)((GAS char*)xout_f32 + 4u * off) = o0; *(GAS f32x4*)((GAS char*)xout_f32 + 4u * off + 16u) = o1; }
                    ss += o0[0] * o0[0] + o0[1] * o0[1] + o0[2] * o0[2] + o0[3] * o0[3] + o1[0] * o1[0] + o1[1] * o1[1] + o1[2] * o1[2] + o1[3] * o1[3];
                }
                ss = xsum16(ss); ss = xsum32(ss);
                if (fq == 0) rss[(size_t)row * 16 + u.pn * 4 + wc] = ss;
            }
    }
};
struct EpiProj {
    static constexpr bool RS_LDS = true, EARLY = false;
    __device__ __forceinline__ void early_rs(int, LAS unsigned char*, int, float (&)[2]) const {}
    __device__ __forceinline__ void early_pair(f32x4 (&)[2][2][4][2], int, int, const float (&)[2]) const {}
    const float* rss; bf16_t* P; int ldp;
    __device__ __forceinline__ void operator()(f32x4 (&acc)[2][2][4][2], const Unit& u, int wr, int wc, int fr, int fq, LAS unsigned char* lds) const {
        const int row0 = u.pm * BM + wr * 64 + fr, c0 = u.pn * BM + wc * 32 + fq * 8;
        float rsv[2][4];
#pragma unroll
        for (int ai = 0; ai < 2; ++ai)
#pragma unroll
            for (int m = 0; m < 4; ++m) rsv[ai][m] = rs_entry(lds, ai * HALF + wr * 64 + m * 16 + fr).x;
        {
#pragma unroll
            for (int ai = 0; ai < 2; ++ai)
#pragma unroll
                for (int m = 0; m < 4; ++m) {
                    const int row = row0 + ai * HALF + m * 16; const float rs = rsv[ai][m];
#pragma unroll
                    for (int bj = 0; bj < 2; ++bj) {
                        const f32x4 v0 = acc[ai][bj][m][0] * rs, v1 = acc[ai][bj][m][1] * rs;
                        u32x4 w; w.x = cvt_pk_bf16(v0[0], v0[1]); w.y = cvt_pk_bf16(v0[2], v0[3]); w.z = cvt_pk_bf16(v1[0], v1[1]); w.w = cvt_pk_bf16(v1[2], v1[3]);
                        *(u32x4*)(P + (size_t)row * ldp + c0 + bj * HALF) = w;
                    }
                }
        }
    }
};
struct EpiMemKV {
    static constexpr bool RS_LDS = false, EARLY = false;
    __device__ __forceinline__ void early_rs(int, LAS unsigned char*, int, float (&)[2]) const {}
    __device__ __forceinline__ void early_pair(f32x4 (&)[2][2][4][2], int, int, const float (&)[2]) const {}
    const float* mrs; bf16_t* MK; bf16_t* MVT; const float* rss;
    __device__ __forceinline__ void operator()(f32x4 (&acc)[2][2][4][2], const Unit& u, int wr, int wc, int fr, int fq, LAS unsigned char* lds) const {
        const int row0 = u.pm * BM + wr * 64 + fr, c0 = u.pn * BM + wc * 32 + fq * 8;
        float rsv[2][4];
#pragma unroll
        for (int ai = 0; ai < 2; ++ai)
#pragma unroll
            for (int m = 0; m < 4; ++m) rsv[ai][m] = mrs[row0 + ai * HALF + m * 16];
#pragma unroll
        for (int ai = 0; ai < 2; ++ai)
#pragma unroll
            for (int m = 0; m < 4; ++m) {
                const int row = row0 + ai * HALF + m * 16;
                const float rs = rsv[ai][m];
#pragma unroll
                for (int bj = 0; bj < 2; ++bj) {
                    const f32x4 v0 = acc[ai][bj][m][0] * rs, v1 = acc[ai][bj][m][1] * rs;
                    const int c = c0 + bj * HALF;
                    if (u.pn < 2) {
                        u32x4 w; w.x = cvt_pk_bf16(v0[0], v0[1]); w.y = cvt_pk_bf16(v0[2], v0[3]); w.z = cvt_pk_bf16(v1[0], v1[1]); w.w = cvt_pk_bf16(v1[2], v1[3]);
                        *(u32x4*)(MK + (size_t)row * 512 + c) = w;
                    } else {
                        const int cv = c - 512, hh = cv >> 7, dv = cv & 127, bb = row >> 8, mm = row & 255;
                        bf16_t* dst = MVT + ((size_t)(bb * 4 + hh) * 128 + dv) * 256 + mm;
#pragma unroll
                        for (int e = 0; e < 4; ++e) { dst[(size_t)e * 256] = (bf16_t)(cvt_pk_bf16(v0[e], 0.f) & 0xffffu); dst[(size_t)(4 + e) * 256] = (bf16_t)(cvt_pk_bf16(v1[e], 0.f) & 0xffffu); }
                    }
                }
            }
    }
};

template <class Epi>
__device__ __forceinline__ void gemm_phase(const int tid, LAS unsigned char* lds, const Gemm g, const StaticOrder& S, const Epi& E) {
    const int wid = __builtin_amdgcn_readfirstlane(tid >> 6), lane = tid & 63, wr = wid >> 2, wc = wid & 3, fr = lane & 15, fq = lane >> 4;
    const int K = g.K, nt = K / BK;
    unsigned voffA[2];
#pragma unroll
    for (int i = 0; i < 2; ++i) { int R, C; stage_rc(tid * 16 + i * 8192, R, C); voffA[i] = (unsigned)(R * K + C) * 2u; }
    const size_t kstep = (size_t)(BK * 2);
    const size_t hstep = (size_t)HALF * K * 2;
    const size_t tstep = 2 * hstep;
    const unsigned ldsw = (unsigned)wid * 1024u;
    const int aoff = lds_byte(wr * 64 + fr, fq * 8), boff = lds_byte(wc * 32 + fr, fq * 8);
#define PG8_SA(b, h) (((b) * 2 + (h)) * HTB)
#define PG8_SB(b, h) ((4 + (b) * 2 + (h)) * HTB)
#define PG8_STAGE(bufoff, gbase) do { _Pragma("unroll") for (int _i = 0; _i < 2; ++_i) \
        __builtin_amdgcn_global_load_lds((const unsigned*)((const char*)(gbase) + voffA[_i]), (LAS unsigned*)(lds + (bufoff) + ldsw + _i * 8192), 16, 0, 0); } while (0)
#define PG8_LDA(dst, b, h) do { _Pragma("unroll") for (int m = 0; m < 4; ++m) _Pragma("unroll") for (int k = 0; k < 2; ++k) dst[m][k] = *(const LAS bf16x8*)(lds + PG8_SA(b, h) + aoff + m * 2048 + k * 1024); } while (0)
#define PG8_LDB(dst, b, h) do { _Pragma("unroll") for (int n = 0; n < 2; ++n) _Pragma("unroll") for (int k = 0; k < 2; ++k) dst[n][k] = *(const LAS bf16x8*)(lds + PG8_SB(b, h) + boff + n * 2048 + k * 1024); } while (0)
#define PG8_MMA(ai, bj, At, Bt) do { __builtin_amdgcn_s_setprio(1); _Pragma("unroll") for (int m = 0; m < 4; ++m) _Pragma("unroll") for (int n = 0; n < 2; ++n) _Pragma("unroll") for (int k = 0; k < 2; ++k) \
        acc[ai][bj][m][n] = __builtin_amdgcn_mfma_f32_16x16x32_bf16(Bt[n][k], At[m][k], acc[ai][bj][m][n], 0, 0, 0); __builtin_amdgcn_s_setprio(0); } while (0)
#define PG8_MMA_E(ai, bj, At, Bt, mh) do { __builtin_amdgcn_s_setprio(1); _Pragma("unroll") for (int _r = 0; _r < 2; ++_r) { float er[2]; E.early_rs(wr, lds, 2 * (mh) + _r, er); \
        _Pragma("unroll") for (int _j = 0; _j < 4; ++_j) { const int _q = 4 * _r + _j, m = _q >> 1, n = _q & 1; \
        acc[ai][bj][m][n] = __builtin_amdgcn_mfma_f32_16x16x32_bf16(Bt[n][0], At[m][0], acc[ai][bj][m][n], 0, 0, 0); \
        acc[ai][bj][m][n] = __builtin_amdgcn_mfma_f32_16x16x32_bf16(Bt[n][1], At[m][1], acc[ai][bj][m][n], 0, 0, 0); \
        E.early_pair(acc, 2 * (mh) + _r, _j, er); __builtin_amdgcn_sched_barrier(0); } } \
        __builtin_amdgcn_s_setprio(0); } while (0)
#define PG8_WAIT_V(n) asm volatile("s_waitcnt vmcnt(" #n ")" ::: "memory")
#define PG8_WAIT_L(n) asm volatile("s_waitcnt lgkmcnt(" #n ")" ::: "memory")
#define PG8_BAR __builtin_amdgcn_s_barrier()
#define PG8_SCHED __builtin_amdgcn_sched_barrier(0)
    Unit cur, nxt; int ui = 0;
    if (!S.next(0, cur)) return;
    f32x4 acc[2][2][4][2];
#pragma unroll
    for (int a = 0; a < 2; ++a)
#pragma unroll
        for (int b = 0; b < 2; ++b)
#pragma unroll
            for (int m = 0; m < 4; ++m)
#pragma unroll
                for (int n = 0; n < 2; ++n) acc[a][b][m][n] = (f32x4){0.f, 0.f, 0.f, 0.f};
    bf16x8 At[4][2], B0[2][2], B1[2][2];
    const char* cA = (const char*)g.A + (size_t)cur.pm * tstep; const char* cB = (const char*)g.Bt + (size_t)cur.pn * tstep;
    PG8_STAGE(PG8_SB(0, 0), cB); PG8_STAGE(PG8_SA(0, 0), cA); PG8_STAGE(PG8_SB(0, 1), cB + hstep); PG8_STAGE(PG8_SA(0, 1), cA + hstep);
    if (wr == 1) PG8_BAR;
    PG8_WAIT_V(4); PG8_BAR;
    PG8_STAGE(PG8_SB(1, 0), cB + kstep); PG8_STAGE(PG8_SA(1, 0), cA + kstep); PG8_STAGE(PG8_SB(1, 1), cB + hstep + kstep);
    PG8_WAIT_V(6); PG8_BAR; PG8_SCHED;
    for (;;) {
        const bool has_next = S.next(ui + 1, nxt);
        const char* nA = has_next ? (const char*)g.A + (size_t)nxt.pm * tstep : cA; const char* nB = has_next ? (const char*)g.Bt + (size_t)nxt.pn * tstep : cB;
#define PG8_ITER(LAST_) do { \
            const char* a1 = cA + (size_t)(t + 1) * kstep; \
            const char* a2 = (LAST_) ? nA : cA + (size_t)(t + 2) * kstep; const char* b2 = (LAST_) ? nB : cB + (size_t)(t + 2) * kstep; \
            const char* a3 = a2 + kstep; const char* b3 = b2 + kstep; \
            if (Epi::RS_LDS && (LAST_)) { \
                int l3_; asm volatile("v_mbcnt_lo_u32_b32 %0, -1, 0\n\tv_mbcnt_hi_u32_b32 %0, -1, %0" : "=v"(l3_)); \
                const char* rsrc = (const char*)E.rss + (size_t)cur.pm * (BM * 64) + (size_t)wid * 2048 + (size_t)l3_ * 16; \
                _Pragma("unroll") for (int _i = 0; _i < 2; ++_i) \
                    __builtin_amdgcn_global_load_lds((const unsigned*)(rsrc + _i * 1024), (LAS unsigned*)(lds + STAGE_BYTES + wid * 2048 + _i * 1024), 16, 0, 0); \
            } \
            PG8_LDB(B0, 0, 0); PG8_SCHED; PG8_LDA(At, 0, 0); PG8_STAGE(PG8_SA(1, 1), a1 + hstep); \
            PG8_WAIT_L(8); PG8_BAR; PG8_WAIT_L(0); PG8_MMA(0, 0, At, B0); PG8_BAR; PG8_SCHED; \
            PG8_LDB(B1, 0, 1); PG8_STAGE(PG8_SB(0, 0), b2); \
            PG8_BAR; PG8_WAIT_L(0); PG8_MMA(0, 1, At, B1); PG8_BAR; \
            PG8_LDA(At, 0, 1); PG8_STAGE(PG8_SA(0, 0), a2); \
            PG8_BAR; PG8_WAIT_L(0); PG8_MMA(1, 0, At, B0); PG8_BAR; PG8_SCHED; \
            PG8_STAGE(PG8_SB(0, 1), b2 + hstep); \
            PG8_WAIT_V(6); PG8_BAR; PG8_MMA(1, 1, At, B1); PG8_BAR; \
            if (Epi::RS_LDS && (LAST_)) rs_finalize(lds, wid); \
            PG8_LDB(B0, 1, 0); PG8_SCHED; PG8_LDA(At, 1, 0); PG8_STAGE(PG8_SA(0, 1), a2 + hstep); \
            PG8_WAIT_L(8); PG8_BAR; PG8_WAIT_L(0); PG8_MMA(0, 0, At, B0); PG8_BAR; PG8_SCHED; \
            PG8_LDB(B1, 1, 1); PG8_STAGE(PG8_SB(1, 0), b3); \
            PG8_BAR; PG8_WAIT_L(0); PG8_MMA(0, 1, At, B1); PG8_BAR; \
            PG8_LDA(At, 1, 1); PG8_STAGE(PG8_SA(1, 0), a3); \
            if (Epi::EARLY && (LAST_)) { \
                PG8_BAR; PG8_WAIT_L(0); PG8_MMA_E(1, 0, At, B0, 0); PG8_BAR; PG8_SCHED; \
                PG8_STAGE(PG8_SB(1, 1), b3 + hstep); \
                PG8_WAIT_V(6); PG8_BAR; PG8_MMA_E(1, 1, At, B1, 1); PG8_BAR; \
            } else { \
                PG8_BAR; PG8_WAIT_L(0); PG8_MMA(1, 0, At, B0); PG8_BAR; PG8_SCHED; \
                PG8_STAGE(PG8_SB(1, 1), b3 + hstep); \
                PG8_WAIT_V(6); PG8_BAR; PG8_MMA(1, 1, At, B1); PG8_BAR; \
            } \
        } while (0)
        if constexpr (Epi::EARLY) {
            for (int t = 0; t < nt - 2; t += 2) PG8_ITER(0);
            {
                const int t = nt - 2; asm volatile("" : "+v"(voffA[0]), "+v"(voffA[1]));
                PG8_ITER(1);
            }
        } else {
            for (int t = 0; t < nt; t += 2) { const bool last_ = (t == nt - 2); PG8_ITER(last_); }
        }
#undef PG8_ITER
        { int l2; asm volatile("v_mbcnt_lo_u32_b32 %0, -1, 0\n\tv_mbcnt_hi_u32_b32 %0, -1, %0" : "=v"(l2));
          E(acc, cur, wr, wc, l2 & 15, l2 >> 4, lds); }
        if (!has_next) break;
#pragma unroll
        for (int a = 0; a < 2; ++a)
#pragma unroll
            for (int b = 0; b < 2; ++b)
#pragma unroll
                for (int m = 0; m < 4; ++m)
#pragma unroll
                    for (int n = 0; n < 2; ++n) acc[a][b][m][n] = (f32x4){0.f, 0.f, 0.f, 0.f};
        cur = nxt; cA = nA; cB = nB; ++ui;
    }
    PG8_WAIT_V(0);
    if (wr == 0) PG8_BAR;
    PG8_BAR;
#undef PG8_SA
#undef PG8_SB
#undef PG8_STAGE
#undef PG8_LDA
#undef PG8_LDB
#undef PG8_MMA
#undef PG8_MMA_E
#undef PG8_WAIT_V
#undef PG8_WAIT_L
#undef PG8_BAR
#undef PG8_SCHED
}
}

enum { MODE_PLAIN = 0, MODE_SWIGLU = 1, MODE_AIN = 2 };
__device__ __forceinline__ void conv_item(const float* W, int Nsrc, int K, bf16_t* WT, const float* gain, float scale, int mode, int item, int npairs, LAS float* scr, int lane) {
    const int kb = item / npairs, P = item % npairs, G = 2 * P, k0 = 64 * kb;
    int cbase = 64 * P, nvalid = 64; float sc = scale;
    if (mode == MODE_SWIGLU) { const int pn = G >> 3, gi = G & 7, bj = gi >> 2, wc = gi & 3; cbase = (bj ? DFF : 0) + 128 * pn + 32 * wc; }
    else if (mode == MODE_AIN) {
        if (G < 16) sc = scale * 0.08838834764831845f;
        if (G >= 96) cbase = 3080 + 32 * (G - 96);
    }
    const int c4 = (lane & 15) * 4, r0 = lane >> 4;
    f32x4 v[16];
#pragma unroll
    for (int i = 0; i < 16; ++i) {
        const int kk = 4 * i + r0;
        v[i] = (f32x4){0.f, 0.f, 0.f, 0.f};
        if (c4 < nvalid) v[i] = *(const f32x4*)(W + (size_t)(k0 + kk) * Nsrc + cbase + c4);
    }
#pragma unroll
    for (int i = 0; i < 16; ++i) {
        const int kk = 4 * i + r0;
        const float gv = gain ? gain[k0 + kk] * sc : sc;
#pragma unroll
        for (int e = 0; e < 4; ++e) scr[kk * 65 + c4 + e] = v[i][e] * gv;
    }
    asm volatile("s_waitcnt lgkmcnt(0)" ::: "memory");
    const int c = lane & 7;
#pragma unroll
    for (int j = 0; j < 8; ++j) {
        const int nu = (lane >> 3) + 8 * j; const LAS float* sp = scr + (8 * c) * 65 + 32 * (nu >> 5) + perm32(nu & 31);
        u32x4 o; o.x = cvt_pk_bf16(sp[0 * 65], sp[1 * 65]); o.y = cvt_pk_bf16(sp[2 * 65], sp[3 * 65]); o.z = cvt_pk_bf16(sp[4 * 65], sp[5 * 65]); o.w = cvt_pk_bf16(sp[6 * 65], sp[7 * 65]);
        *(u32x4*)(WT + (size_t)(64 * P + nu) * K + k0 + 8 * c) = o;
    }
    asm volatile("s_waitcnt lgkmcnt(0)" ::: "memory");
}

__device__ __forceinline__ void convert_phase(const int tid, const Params& p, unsigned char* ws, int L, LAS unsigned char* lds, const int gw, const int NGW, const bool prologue) {
    const int lane = tid & 63, wave = tid >> 6;
    unsigned char* wsl = ws + ((L & 1) ? WS_SET1 : (size_t)0);
    LAS float* scr = (LAS float*)(lds + wave * 16640);
    const int j = L >> 1; const bool isA = (L & 1) == 0;
    const int I_WIN = 16 * 88, I_WOUT = 44 * 16, I_MIN = isA ? 16 * 56 : 16 * 28, I_MOUT = 24 * 16, I_MEM = prologue ? 16 * 16 : 0;
    const int total = 2 * I_WIN + 2 * I_WOUT + I_MIN + I_MOUT + I_MEM;
    for (int it = gw; it < total; it += NGW) {
        int r = it;
        if (r < I_WIN) { conv_item(INP(6) + (size_t)L * DM * 2 * DFF, 2 * DFF, DM, (bf16_t*)(wsl + WS_WIN0), INP(5) + L * DM, 1.f, MODE_SWIGLU, r, 88, scr, lane); continue; } r -= I_WIN;
        if (r < I_WIN) { conv_item(INP(10) + (size_t)L * DM * 2 * DFF, 2 * DFF, DM, (bf16_t*)(wsl + WS_WIN1), INP(9) + L * DM, 1.f, MODE_SWIGLU, r, 88, scr, lane); continue; } r -= I_WIN;
        if (r < I_WOUT) { conv_item(INP(7) + (size_t)L * DFF * DM, DM, DFF, (bf16_t*)(wsl + WS_WOUT0), nullptr, 0.5f, MODE_PLAIN, r, 16, scr, lane); continue; } r -= I_WOUT;
        if (r < I_WOUT) { conv_item(INP(11) + (size_t)L * DFF * DM, DM, DFF, (bf16_t*)(wsl + WS_WOUT1), nullptr, 0.5f, MODE_PLAIN, r, 16, scr, lane); continue; } r -= I_WOUT;
        if (r < I_MIN) {
            if (isA) conv_item(INP(14) + (size_t)j * DM * A_INW, A_INW, DM, (bf16_t*)(wsl + WS_MIN), INP(8) + L * DM, 1.f, MODE_AIN, r, 56, scr, lane);
            else conv_item(INP(18) + (size_t)j * DM * B_INW, B_INW, DM, (bf16_t*)(wsl + WS_MIN), INP(8) + L * DM, 1.f, MODE_PLAIN, r, 28, scr, lane);
            continue; } r -= I_MIN;
        if (r < I_MOUT) { conv_item((isA ? INP(17) : INP(22)) + (size_t)j * OUTK * DM, DM, OUTK, (bf16_t*)(wsl + WS_MOUT), nullptr, 1.f, MODE_PLAIN, r, 16, scr, lane); continue; } r -= I_MOUT;
        conv_item(INP(4), 1024, DM, (bf16_t*)(ws + WS_MEMW), INP(3), 1.f, MODE_PLAIN, r, 16, scr, lane);
    }
    if (isA) {
        const float* W = INP(14) + (size_t)j * DM * A_INW; const float* gain = INP(8) + L * DM; bf16_t* WG = (bf16_t*)(wsl + WS_WG);
        for (int idx = gw * 64 + lane; idx < 16 * DM; idx += NGW * 64) {
            const int r = idx >> 10, k2 = idx & 1023;
            const float v = (r < 8) ? W[(size_t)k2 * A_INW + 3072 + r] * gain[k2] : 0.f;
            WG[idx] = (bf16_t)(cvt_pk_bf16(v, 0.f) & 0xffffu);
        }
    }
    if (prologue) {
        bf16_t* xb = (bf16_t*)(ws + WS_XB); float* rss = (float*)(ws + WS_RSS);
        for (int rowb = gw; rowb < MTOK; rowb += 4 * NGW) {
            f32x4 v[4][4];
#pragma unroll
            for (int i = 0; i < 4; ++i) { const int row = rowb + i * NGW; const f32x4* xr = (const f32x4*)(INP(0) + (size_t)(row < MTOK ? row : 0) * DM) + lane;
#pragma unroll
                for (int q = 0; q < 4; ++q) v[i][q] = xr[64 * q]; }
#pragma unroll
            for (int i = 0; i < 4; ++i) {
                const int row = rowb + i * NGW;
                if (row < MTOK) {
                    float s = 0.f;
                    unsigned long long* o8 = (unsigned long long*)(xb + (size_t)row * DM) + lane;
                    unsigned* l4 = (unsigned*)(ws + WS_Y + (size_t)row * DM) + lane;
#pragma unroll
                    for (int q = 0; q < 4; ++q) { const f32x4 vv = v[i][q]; s += vv[0] * vv[0] + vv[1] * vv[1] + vv[2] * vv[2] + vv[3] * vv[3];
                        unsigned w0, w1; const unsigned c0_ = pg8::xenc2(vv[0], vv[1], w0), c1_ = pg8::xenc2(vv[2], vv[3], w1);
                        o8[64 * q] = (unsigned long long)w0 | ((unsigned long long)w1 << 32);
                        l4[64 * q] = c0_ | (c1_ << 16); }
                    s = wave_sum(s);
                    if (lane < 16) rss[(size_t)row * 16 + lane] = (lane == 0) ? s : 0.f;
                }
            }
        }
        bf16_t* mb = (bf16_t*)(ws + WS_MEMB); float* mrs = (float*)(ws + WS_MEMRS);
        for (int row = gw; row < MROWS; row += NGW) {
            const f32x4* xr = (const f32x4*)(INP(1) + (size_t)row * DM) + lane; float s = 0.f;
            unsigned long long* o8 = (unsigned long long*)(mb + (size_t)row * DM) + lane;
#pragma unroll
            for (int q = 0; q < 4; ++q) { const f32x4 v = xr[64 * q]; s += v[0] * v[0] + v[1] * v[1] + v[2] * v[2] + v[3] * v[3];
                o8[64 * q] = (unsigned long long)cvt_pk_bf16(v[0], v[1]) | ((unsigned long long)cvt_pk_bf16(v[2], v[3]) << 32); }
            s = wave_sum(s);
            if (lane == 0) mrs[row] = 1.0f / sqrtf(s * (1.0f / 1024.0f) + EPS);
        }
        float* rope = (float*)(ws + WS_ROPE); const int* pos = (const int*)INP(2);
        for (int e = blockIdx.x * NTHREADS + tid; e < MTOK * 8; e += gridDim.x * NTHREADS) {
            const int tok = e >> 3, i = e & 7;
            const float ang = (float)pos[tok] * __builtin_amdgcn_exp2f((float)i * (-18.931568569324174f / 8.0f));
            const float kq = rintf(ang * 0.636619772367581343f);
            float t = fmaf(-kq, 1.5703125f, ang); t = fmaf(-kq, 4.837512969970703125e-4f, t); t = fmaf(-kq, 7.54978995489188e-8f, t);
            const float t2 = t * t;
            const float sn = t * (1.0f + t2 * (-1.0f / 6 + t2 * (1.0f / 120 + t2 * (-1.0f / 5040 + t2 * (1.0f / 362880)))));
            const float cs = 1.0f + t2 * (-0.5f + t2 * (1.0f / 24 + t2 * (-1.0f / 720 + t2 * (1.0f / 40320 + t2 * (-1.0f / 3628800)))));
            const int q = ((int)kq) & 3;
            float c_, s_;
            if (q == 0) { c_ = cs; s_ = sn; } else if (q == 1) { c_ = -sn; s_ = cs; } else if (q == 2) { c_ = -cs; s_ = -sn; } else { c_ = sn; s_ = -cs; }
            rope[(size_t)tok * 16 + i] = c_; rope[(size_t)tok * 16 + 8 + i] = s_;
        }
    }
}

constexpr int LDK_M = 136, LDV_M = 264;
__device__ __forceinline__ void mem_attn_item(const int tid, const Params& p, unsigned char* ws, int L, int item, const bf16_t* proj, int ldp, int xq_off, bf16_t* Y, LAS unsigned char* lds) {
    const int lane = tid & 63, wave = tid >> 6, g = lane >> 4, c = lane & 15;
    const int b = item >> 5, h = (item >> 3) & 3, tile = item & 7;
    LAS bf16_t* Kh = (LAS bf16_t*)lds;
    LAS bf16_t* VT = (LAS bf16_t*)(lds + 256 * LDK_M * 2);
    LAS float* GG = (LAS float*)(lds + 256 * LDK_M * 2 + 128 * LDV_M * 2);
    const bf16_t* MK = (const bf16_t*)(ws + WS_MEMK); const bf16_t* MVT = (const bf16_t*)(ws + WS_MEMVT);
    __syncthreads();
    if (tid < 128) GG[tid] = INP(12)[L * 128 + tid] * INP(13)[L * 128 + tid] * 0.08838834764831845f;
    {
        const int ch = tid & 15;
#pragma unroll
        for (int it = 0; it < 8; ++it) {
            const int m = (tid >> 4) + 32 * it;
            const u32x4 w = *(const u32x4*)(MK + (size_t)(b * 256 + m) * 512 + h * 128 + ch * 8);
            float v[8] = {bflo(w.x), bfhi(w.x), bflo(w.y), bfhi(w.y), bflo(w.z), bfhi(w.z), bflo(w.w), bfhi(w.w)};
            float s = 0.f;
#pragma unroll
            for (int e = 0; e < 8; ++e) s += v[e] * v[e];
            s = rowsum16(s);
            const float rs = 1.0f / sqrtf(s * (1.0f / 128.0f) + EPS);
            u32x4 o; o.x = cvt_pk_bf16(v[0] * rs, v[1] * rs); o.y = cvt_pk_bf16(v[2] * rs, v[3] * rs); o.z = cvt_pk_bf16(v[4] * rs, v[5] * rs); o.w = cvt_pk_bf16(v[6] * rs, v[7] * rs);
            *(LAS u32x4*)(Kh + m * LDK_M + ch * 8) = o;
        }
        const int ch2 = tid & 31;
#pragma unroll
        for (int it = 0; it < 8; ++it) {
            const int dv = (tid >> 5) + 16 * it;
            const u32x4 w = *(const u32x4*)(MVT + ((size_t)(b * 4 + h) * 128 + dv) * 256 + ch2 * 8);
            *(LAS u32x4*)(VT + dv * LDV_M + ch2 * 8) = w;
        }
    }
    __syncthreads();
#pragma unroll 1
    for (int qt = 0; qt < 2; ++qt) {
        const int tok = tile * 256 + wave * 32 + qt * 16 + c;
        const size_t row = (size_t)b * SEQ + tok;
        bf16x8 qf[4];
        {
            float v[4][8]; float s = 0.f;
#pragma unroll
            for (int ds = 0; ds < 4; ++ds) {
                const u32x4 w = *(const u32x4*)(proj + row * ldp + xq_off + h * 128 + 32 * ds + 8 * g);
                v[ds][0] = bflo(w.x); v[ds][1] = bfhi(w.x); v[ds][2] = bflo(w.y); v[ds][3] = bfhi(w.y); v[ds][4] = bflo(w.z); v[ds][5] = bfhi(w.z); v[ds][6] = bflo(w.w); v[ds][7] = bfhi(w.w);
#pragma unroll
                for (int e = 0; e < 8; ++e) s += v[ds][e] * v[ds][e];
            }
            s = xsum16(s); s = xsum32(s);
            const float rs = 1.0f / sqrtf(s * (1.0f / 128.0f) + EPS);
#pragma unroll
            for (int ds = 0; ds < 4; ++ds) {
                float t[8];
#pragma unroll
                for (int e = 0; e < 8; ++e) t[e] = v[ds][e] * rs * GG[32 * ds + 8 * g + e];
                u32x4 o; o.x = cvt_pk_bf16(t[0], t[1]); o.y = cvt_pk_bf16(t[2], t[3]); o.z = cvt_pk_bf16(t[4], t[5]); o.w = cvt_pk_bf16(t[6], t[7]);
                qf[ds] = __builtin_bit_cast(bf16x8, o);
            }
        }
        f32x4 st[16];
#pragma unroll
        for (int kt = 0; kt < 16; ++kt) {
            f32x4 a = {0.f, 0.f, 0.f, 0.f};
#pragma unroll
            for (int ds = 0; ds < 4; ++ds) a = mfma16(lds8(Kh, LDK_M, 16 * kt + c, 32 * ds + 8 * g), qf[ds], a);
            st[kt] = a;
            if ((kt & 3) == 3) __builtin_amdgcn_sched_barrier(0);
        }
        float mx = -3.0e38f;
#pragma unroll
        for (int kt = 0; kt < 16; ++kt)
#pragma unroll
            for (int r = 0; r < 4; ++r) mx = fmaxf(mx, st[kt][r]);
        mx = xmax16(mx); mx = xmax32(mx);
        float sum = 0.f;
#pragma unroll
        for (int kt = 0; kt < 16; ++kt)
#pragma unroll
            for (int r = 0; r < 4; ++r) { const float e = fast_exp(st[kt][r] - mx); st[kt][r] = e; sum += e; }
        sum = xsum16(sum); sum = xsum32(sum);
        const float inv = 1.0f / sum;
        f32x4 o[8];
#pragma unroll
        for (int dt = 0; dt < 8; ++dt) o[dt] = (f32x4){0.f, 0.f, 0.f, 0.f};
#pragma unroll
        for (int u = 0; u < 8; ++u) {
            const bf16x8 pb = pack8(st[2 * u], st[2 * u + 1]);
#pragma unroll
            for (int dt = 0; dt < 8; ++dt) o[dt] = mfma16(lds4x2(VT, LDV_M, 16 * dt + c, 32 * u + 4 * g), pb, o[dt]);
        }
#pragma unroll
        for (int dt = 0; dt < 8; ++dt) {
            u32x2 w; w.x = cvt_pk_bf16(o[dt][0] * inv, o[dt][1] * inv); w.y = cvt_pk_bf16(o[dt][2] * inv, o[dt][3] * inv);
            *(u32x2*)(Y + row * OUTK + 1024 + h * 128 + 16 * dt + 4 * g) = w;
        }
    }
}

constexpr int LDK_S = 72, LDV_S = 264;
__device__ __forceinline__ void swa_item(const int tid, const Params& p, unsigned char* ws, int jb, int item, const bf16_t* proj, bf16_t* Y, LAS unsigned char* lds) {
    const int lane = tid & 63, wave = tid >> 6, g = lane >> 4, c = lane & 15;
    const int b = item >> 5, n = (item >> 1) & 15, kvh = item & 1;
    LAS bf16_t* Kn = (LAS bf16_t*)lds;
    LAS bf16_t* VT = (LAS bf16_t*)(lds + 256 * LDK_S * 2);
    LAS float* GQ = (LAS float*)(lds + 256 * LDK_S * 2 + 64 * LDV_S * 2);
    const float* rope = (const float*)(ws + WS_ROPE);
    __syncthreads();
    if (tid < 64) { GQ[tid] = INP(19)[jb * 64 + tid]; GQ[64 + tid] = INP(20)[jb * 64 + tid]; }
    __syncthreads();
    {
        const int ch = tid & 7;
#pragma unroll
        for (int it = 0; it < 4; ++it) {
            const int kj = (tid >> 3) + 64 * it;
            const int tok = (n - 1) * 128 + kj;
            u32x4 ko = {0u, 0u, 0u, 0u}; float vv[8] = {0.f, 0.f, 0.f, 0.f, 0.f, 0.f, 0.f, 0.f};
            const bool ok = tok >= 0;
            const size_t row = (size_t)b * SEQ + (ok ? tok : 0);
            const u32x4 kw = *(const u32x4*)(proj + row * B_INW + 1024 + kvh * 64 + ch * 8);
            const u32x4 vw = *(const u32x4*)(proj + row * B_INW + 1152 + kvh * 64 + ch * 8);
            float kv[8] = {bflo(kw.x), bfhi(kw.x), bflo(kw.y), bfhi(kw.y), bflo(kw.z), bfhi(kw.z), bflo(kw.w), bfhi(kw.w)};
            float s = 0.f;
#pragma unroll
            for (int e = 0; e < 8; ++e) s += kv[e] * kv[e];
            s = rowsum8(s);
            const float rs = 1.0f / sqrtf(s * (1.0f / 64.0f) + EPS);
#pragma unroll
            for (int e = 0; e < 8; ++e) kv[e] = kv[e] * rs * GQ[64 + ch * 8 + e];
            float other[8];
#pragma unroll
            for (int e = 0; e < 8; ++e) other[e] = dpp_x1(kv[e]);
            if (ch < 2) {
                const f32x4 c0 = *(const f32x4*)(rope + row * 16), c1 = *(const f32x4*)(rope + row * 16 + 4), s0 = *(const f32x4*)(rope + row * 16 + 8), s1 = *(const f32x4*)(rope + row * 16 + 12);
                const float cs[8] = {c0[0], c0[1], c0[2], c0[3], c1[0], c1[1], c1[2], c1[3]}, sn[8] = {s0[0], s0[1], s0[2], s0[3], s1[0], s1[1], s1[2], s1[3]};
#pragma unroll
                for (int e = 0; e < 8; ++e) kv[e] = (ch == 0) ? (kv[e] * cs[e] - other[e] * sn[e]) : (kv[e] * cs[e] + other[e] * sn[e]);
            }
            if (ok) {
                ko.x = cvt_pk_bf16(kv[0], kv[1]); ko.y = cvt_pk_bf16(kv[2], kv[3]); ko.z = cvt_pk_bf16(kv[4], kv[5]); ko.w = cvt_pk_bf16(kv[6], kv[7]);
            }
            *(LAS u32x4*)(Kn + kj * LDK_S + ch * 8) = ko;
            const unsigned vws[4] = {ok ? vw.x : 0u, ok ? vw.y : 0u, ok ? vw.z : 0u, ok ? vw.w : 0u};
#pragma unroll
            for (int e = 0; e < 4; ++e) { VT[(ch * 8 + 2 * e) * LDV_S + kj] = (bf16_t)(vws[e] & 0xffffu); VT[(ch * 8 + 2 * e + 1) * LDV_S + kj] = (bf16_t)(vws[e] >> 16); }
            (void)vv;
        }
    }
    __syncthreads();
    const int head = kvh * 8 + wave;
    const float sink = INP(21)[jb * 16 + head];
#pragma unroll 1
    for (int i = 0; i < 4; ++i) {
        bf16x8 qf[2][2];
#pragma unroll
        for (int qt = 0; qt < 2; ++qt) {
            const int tok = n * 128 + 32 * i + 16 * qt + c;
            const size_t row = (size_t)b * SEQ + tok;
            float v[2][8]; float s = 0.f;
#pragma unroll
            for (int ds = 0; ds < 2; ++ds) {
                const u32x4 w = *(const u32x4*)(proj + row * B_INW + head * 64 + 32 * ds + 8 * g);
                v[ds][0] = bflo(w.x); v[ds][1] = bfhi(w.x); v[ds][2] = bflo(w.y); v[ds][3] = bfhi(w.y); v[ds][4] = bflo(w.z); v[ds][5] = bfhi(w.z); v[ds][6] = bflo(w.w); v[ds][7] = bfhi(w.w);
#pragma unroll
                for (int e = 0; e < 8; ++e) s += v[ds][e] * v[ds][e];
            }
            s = xsum16(s); s = xsum32(s);
            const float rs = 1.0f / sqrtf(s * (1.0f / 64.0f) + EPS);
#pragma unroll
            for (int ds = 0; ds < 2; ++ds)
#pragma unroll
                for (int e = 0; e < 8; ++e) v[ds][e] = v[ds][e] * rs * GQ[32 * ds + 8 * g + e];
            {
                float other[8];
#pragma unroll
                for (int e = 0; e < 8; ++e) other[e] = shfl_from(v[0][e], lane ^ 16);
                if (g < 2) {
                    const f32x4 c0 = *(const f32x4*)(rope + row * 16), c1 = *(const f32x4*)(rope + row * 16 + 4), s0 = *(const f32x4*)(rope + row * 16 + 8), s1 = *(const f32x4*)(rope + row * 16 + 12);
                    const float cs[8] = {c0[0], c0[1], c0[2], c0[3], c1[0], c1[1], c1[2], c1[3]}, sn[8] = {s0[0], s0[1], s0[2], s0[3], s1[0], s1[1], s1[2], s1[3]};
#pragma unroll
                    for (int e = 0; e < 8; ++e) v[0][e] = (g == 0) ? (v[0][e] * cs[e] - other[e] * sn[e]) : (v[0][e] * cs[e] + other[e] * sn[e]);
                }
            }
#pragma unroll
            for (int ds = 0; ds < 2; ++ds) {
                u32x4 o; o.x = cvt_pk_bf16(v[ds][0] * 0.125f, v[ds][1] * 0.125f); o.y = cvt_pk_bf16(v[ds][2] * 0.125f, v[ds][3] * 0.125f);
                o.z = cvt_pk_bf16(v[ds][4] * 0.125f, v[ds][5] * 0.125f); o.w = cvt_pk_bf16(v[ds][6] * 0.125f, v[ds][7] * 0.125f);
                qf[qt][ds] = __builtin_bit_cast(bf16x8, o);
            }
        }
        f32x4 st[10][2];
#pragma unroll
        for (int kt = 0; kt < 10; ++kt) {
            const bf16x8 k0 = lds8(Kn, LDK_S, 32 * i + 16 * kt + c, 8 * g), k1 = lds8(Kn, LDK_S, 32 * i + 16 * kt + c, 32 + 8 * g);
#pragma unroll
            for (int qt = 0; qt < 2; ++qt) { f32x4 a = {0.f, 0.f, 0.f, 0.f}; a = mfma16(k0, qf[qt][0], a); a = mfma16(k1, qf[qt][1], a); st[kt][qt] = a; }
        }
        float inv[2];
#pragma unroll
        for (int qt = 0; qt < 2; ++qt) {
            float mx = sink;
#pragma unroll
            for (int kt = 0; kt < 10; ++kt)
#pragma unroll
                for (int r = 0; r < 4; ++r) {
                    const int kj = 32 * i + 16 * kt + 4 * g + r, diff = 128 + 32 * i + 16 * qt + c - kj;
                    const bool valid = (diff >= 0) && (diff < 128) && (n > 0 || kj >= 128);
                    const float sv = valid ? st[kt][qt][r] : -3.0e38f; st[kt][qt][r] = sv; mx = fmaxf(mx, sv);
                }
            mx = xmax16(mx); mx = xmax32(mx);
            float sum = 0.f;
#pragma unroll
            for (int kt = 0; kt < 10; ++kt)
#pragma unroll
                for (int r = 0; r < 4; ++r) { const float sv = st[kt][qt][r]; const float e = (sv > -1.0e38f) ? fast_exp(sv - mx) : 0.f; st[kt][qt][r] = e; sum += e; }
            sum = xsum16(sum); sum = xsum32(sum);
            inv[qt] = 1.0f / (sum + fast_exp(sink - mx));
        }
        f32x4 o[4][2];
#pragma unroll
        for (int dt = 0; dt < 4; ++dt)
#pragma unroll
            for (int qt = 0; qt < 2; ++qt) o[dt][qt] = (f32x4){0.f, 0.f, 0.f, 0.f};
#pragma unroll
        for (int u = 0; u < 5; ++u) {
            const bf16x8 pb0 = pack8(st[2 * u][0], st[2 * u + 1][0]), pb1 = pack8(st[2 * u][1], st[2 * u + 1][1]);
#pragma unroll
            for (int dt = 0; dt < 4; ++dt) {
                const bf16x8 vf = lds4x2(VT, LDV_S, 16 * dt + c, 32 * i + 32 * u + 4 * g);
                o[dt][0] = mfma16(vf, pb0, o[dt][0]); o[dt][1] = mfma16(vf, pb1, o[dt][1]);
            }
        }
#pragma unroll
        for (int qt = 0; qt < 2; ++qt) {
            const int tok = n * 128 + 32 * i + 16 * qt + c;
            const size_t row = (size_t)b * SEQ + tok;
#pragma unroll
            for (int dt = 0; dt < 4; ++dt) {
                u32x2 w; w.x = cvt_pk_bf16(o[dt][qt][0] * inv[qt], o[dt][qt][1] * inv[qt]); w.y = cvt_pk_bf16(o[dt][qt][2] * inv[qt], o[dt][qt][3] * inv[qt]);
                *(u32x2*)(Y + row * OUTK + head * 64 + 16 * dt + 4 * g) = w;
            }
        }
    }
}

typedef short s16x4 __attribute__((ext_vector_type(4)));
__device__ __forceinline__ bf16x8 ldstr8(const LAS bf16_t* base, int ld, int s0, int col0, int i, int hi_row_off) {
    const LAS bf16_t* a = base + (s0 + (i >> 2)) * ld + col0 + 4 * (i & 3);
    const s16x4 lo = __builtin_amdgcn_ds_read_tr16_b64_v4i16((LAS s16x4*)a);
    const s16x4 hi = __builtin_amdgcn_ds_read_tr16_b64_v4i16((LAS s16x4*)(a + hi_row_off * ld));
    return (bf16x8){lo.x, lo.y, lo.z, lo.w, hi.x, hi.y, hi.z, hi.w};
}
constexpr int LDQ_A = 136, LDT_A = 72, LDV_A = 264;
constexpr int ML_QS = 0, ML_KS = ML_QS + 64 * LDQ_A * 2, ML_KW = ML_KS + 64 * LDQ_A * 2, ML_VS = ML_KW + 64 * LDQ_A * 2, ML_SS = ML_VS + 64 * LDV_A * 2,
              ML_A = ML_SS + 64 * LDT_A * 2, ML_PM = ML_A + 2048 * 4, ML_MM = ML_PM + 2048 * 4, ML_MST = ML_MM + 2048 * 4, ML_NV = ML_MST + 64 * 4, ML_QN = ML_NV + 128 * 4,
              ML_DENP = ML_QN + 64 * 4, ML_HSQ = ML_DENP + 128 * 4, ML_NVP = ML_HSQ + 512 * 4, ML_END = ML_NVP + 512 * 4;
static_assert(ML_END <= LDS_BYTES - 16, "mLSTM LDS");
constexpr int ML_GROUPS = 4, ML_CPG = 32 / ML_GROUPS, ML_SLOT = 256 * 128 + 128;
constexpr size_t WS_MLST = WS_Y + (size_t)34 * 1024 * 1024;
template <int MODE>
__device__ __forceinline__ void mlstm_item(const int tid_in, const Params& p, unsigned char* ws, int ja, int item, int grp, const bf16_t* proj, bf16_t* Y, LAS unsigned char* lds) {
    int tid = tid_in;
    int lane = tid & 63, wave = __builtin_amdgcn_readfirstlane(tid >> 6), g = lane >> 4, c = lane & 15;
    const int b = item >> 2, h = item & 3;
    LAS bf16_t* Qs = (LAS bf16_t*)(lds + ML_QS); LAS bf16_t* Ks = (LAS bf16_t*)(lds + ML_KS); LAS bf16_t* Kw = (LAS bf16_t*)(lds + ML_KW);
    LAS bf16_t* Vs = (LAS bf16_t*)(lds + ML_VS); LAS bf16_t* Ss = (LAS bf16_t*)(lds + ML_SS);
    LAS float* A_ = (LAS float*)(lds + ML_A); LAS float* PM_ = (LAS float*)(lds + ML_PM); LAS float* MM_ = (LAS float*)(lds + ML_MM); LAS float* MST_ = (LAS float*)(lds + ML_MST);
    LAS float* NV = (LAS float*)(lds + ML_NV); LAS float* QN = (LAS float*)(lds + ML_QN); LAS float* DENP = (LAS float*)(lds + ML_DENP); LAS float* HSQ = (LAS float*)(lds + ML_HSQ); LAS float* NVP = (LAS float*)(lds + ML_NVP);
    const float* gates = (const float*)(ws + WS_GATES);
    const float* hg = INP(16) + ja * 1024 + h * 256;
    float* SB = (float*)(ws + WS_MLST);
    const GAS char* projb = (const GAS char*)proj; GAS char* Yb8 = (GAS char*)Y;
    const int ck0 = grp * ML_CPG, ck1 = ck0 + ML_CPG;
    __syncthreads();
#pragma unroll 1
    for (int cc = 0; cc < 4; ++cc) {
        const int t = 64 * (4 * wave + cc) + lane; const size_t row = (size_t)b * SEQ + t;
        const float ip = gates[row * 8 + h], lf = gates[row * 8 + 4 + h];
        float bs = lf;
#pragma unroll
        for (int o = 1; o < 64; o <<= 1) { const float v2 = shfl_from(bs, lane >= o ? lane - o : lane); if (lane >= o) bs += v2; }
        const float a = ip - bs; float pm = a;
#pragma unroll
        for (int o = 1; o < 64; o <<= 1) { const float v2 = shfl_from(pm, lane >= o ? lane - o : lane); if (lane >= o) pm = fmaxf(pm, v2); }
        A_[t] = a; PM_[t] = pm; MM_[t] = bs;
    }
    if (tid < 128) NV[tid] = 0.f;
    __syncthreads();
    if (tid == 0) { float m = 0.f; for (int ck = 0; ck < 32; ++ck) { MST_[ck] = m; m = MM_[64 * ck + 63] + fmaxf(m, PM_[64 * ck + 63]); } }
    __syncthreads();
#pragma unroll
    for (int q = 0; q < 4; ++q) { const int t = tid + 512 * q; const float pm = fmaxf(MST_[t >> 6], PM_[t]); PM_[t] = pm; MM_[t] = MM_[t] + pm; }
    f32x4 st[8][2];
#pragma unroll
    for (int mt = 0; mt < 8; ++mt)
#pragma unroll
        for (int vt = 0; vt < 2; ++vt) st[mt][vt] = (f32x4){0.f, 0.f, 0.f, 0.f};
    if (MODE == 2 && grp > 0) {
        __syncthreads();
#pragma unroll 1
        for (int gp = 0; gp < grp; ++gp) {
            float ex = 0.f;
            for (int k2 = (gp + 1) * ML_CPG; k2 < ck0; ++k2) ex += MST_[k2] - PM_[64 * k2 + 63];
            const float wgt = fast_exp(ex);
            const float* sl = SB + (size_t)((b * 4 + h) * 3 + gp) * ML_SLOT;
#pragma unroll
            for (int mt = 0; mt < 8; ++mt)
#pragma unroll
                for (int vt = 0; vt < 2; ++vt) st[mt][vt] += wgt * *(const f32x4*)(sl + (32 * wave + 16 * vt + c) * 128 + 16 * mt + 4 * g);
            if (tid < 128) NV[tid] += wgt * sl[256 * 128 + tid];
        }
    }
    u32x4 qreg[2], kreg[2], vreg[4];
    {
        const unsigned row0 = (unsigned)(b * SEQ + 64 * ck0);
#pragma unroll
        for (int it = 0; it < 2; ++it) { const int idx = tid + 512 * it, s_ = idx >> 4, ch = idx & 15;
            if (MODE == 2) qreg[it] = *(const GAS u32x4*)(projb + ((row0 + s_) * A_LDP + h * 128 + ch * 8) * 2u);
            kreg[it] = *(const GAS u32x4*)(projb + ((row0 + s_) * A_LDP + 512 + h * 128 + ch * 8) * 2u); }
#pragma unroll
        for (int it = 0; it < 4; ++it) { const int idx = tid + 512 * it, s_ = idx >> 5, ch = idx & 31; vreg[it] = *(const GAS u32x4*)(projb + ((row0 + s_) * A_LDP + 1024 + h * 256 + ch * 8) * 2u); }
    }
#pragma unroll 1
    for (int ck = ck0; ck < ck1; ++ck) {
        const int t0 = 64 * ck; const unsigned row0 = (unsigned)(b * SEQ + t0);
        asm volatile("" : "+v"(tid)); lane = tid & 63; g = lane >> 4; c = lane & 15;
        __syncthreads();
        const float m_st = MST_[ck], pm_last = PM_[t0 + 63];
        if (ck > ck0 && tid < 128) {
            const float dprev = fast_exp(MST_[ck - 1] - PM_[t0 - 1]);
            NV[tid] = dprev * NV[tid] + ((NVP[tid] + NVP[128 + tid]) + (NVP[256 + tid] + NVP[384 + tid]));
        }
        {
#pragma unroll
            for (int it = 0; it < 2; ++it) {
                const int idx = tid + 512 * it, s_ = idx >> 4, ch = idx & 15;
                const u32x4 kw = kreg[it];
                if (MODE == 2) { *(LAS u32x4*)(Qs + s_ * LDQ_A + ch * 8) = qreg[it]; *(LAS u32x4*)(Ks + s_ * LDQ_A + ch * 8) = kw; }
                const float w = fast_exp(A_[t0 + s_] - pm_last);
                u32x4 o; o.x = cvt_pk_bf16(bflo(kw.x) * w, bfhi(kw.x) * w); o.y = cvt_pk_bf16(bflo(kw.y) * w, bfhi(kw.y) * w); o.z = cvt_pk_bf16(bflo(kw.z) * w, bfhi(kw.z) * w); o.w = cvt_pk_bf16(bflo(kw.w) * w, bfhi(kw.w) * w);
                *(LAS u32x4*)(Kw + s_ * LDQ_A + ch * 8) = o;
            }
#pragma unroll
            for (int it = 0; it < 4; ++it) { const int idx = tid + 512 * it, s_ = idx >> 5, ch = idx & 31; *(LAS u32x4*)(Vs + s_ * LDV_A + ch * 8) = vreg[it]; }
        }
        u32x2 ogr[4][2];
        if (MODE == 2) {
#pragma unroll
            for (int jt = 0; jt < 4; ++jt)
#pragma unroll
                for (int vt = 0; vt < 2; ++vt) ogr[jt][vt] = *(const GAS u32x2*)(projb + ((row0 + 16 * jt + c) * A_LDP + 2048 + h * 256 + 32 * wave + 16 * vt + 4 * g) * 2u);
        }
        if (ck + 1 < ck1) {
            const unsigned rown = row0 + 64u;
#pragma unroll
            for (int it = 0; it < 2; ++it) { const int idx = tid + 512 * it, s_ = idx >> 4, ch = idx & 15;
                if (MODE == 2) qreg[it] = *(const GAS u32x4*)(projb + ((rown + s_) * A_LDP + h * 128 + ch * 8) * 2u);
                kreg[it] = *(const GAS u32x4*)(projb + ((rown + s_) * A_LDP + 512 + h * 128 + ch * 8) * 2u); }
#pragma unroll
            for (int it = 0; it < 4; ++it) { const int idx = tid + 512 * it, s_ = idx >> 5, ch = idx & 31; vreg[it] = *(const GAS u32x4*)(projb + ((rown + s_) * A_LDP + 1024 + h * 256 + ch * 8) * 2u); }
        }
        __syncthreads();
        if constexpr (MODE == 2) {
        {
            const int j = tid >> 3, part = tid & 7; float s = 0.f;
#pragma unroll
            for (int hh = 0; hh < 2; ++hh) {
                const u32x4 qw = *(const LAS u32x4*)(Qs + j * LDQ_A + 16 * part + 8 * hh);
                const f32x4 n0 = *(const LAS f32x4*)(NV + 16 * part + 8 * hh), n1 = *(const LAS f32x4*)(NV + 16 * part + 8 * hh + 4);
                s += bflo(qw.x) * n0[0] + bfhi(qw.x) * n0[1] + bflo(qw.y) * n0[2] + bfhi(qw.y) * n0[3] + bflo(qw.z) * n1[0] + bfhi(qw.z) * n1[1] + bflo(qw.w) * n1[2] + bfhi(qw.w) * n1[3];
            }
            s = rowsum8(s);
            if (part == 0) QN[j] = s;
        }
        {
            const int jt = wave >> 1, sp = wave & 1;
            float dsum[4] = {0.f, 0.f, 0.f, 0.f};
#pragma unroll
            for (int q = 0; q < 2; ++q) {
                const int stl = 2 * sp + q;
                f32x4 a = {0.f, 0.f, 0.f, 0.f};
                if (stl <= jt) {
#pragma unroll
                    for (int ds = 0; ds < 4; ++ds) a = mfma16(lds8(Qs, LDQ_A, 16 * jt + c, 32 * ds + 8 * g), lds8(Ks, LDQ_A, 16 * stl + c, 32 * ds + 8 * g), a);
                }
                const int s = 16 * stl + c; const float as = A_[t0 + s];
#pragma unroll
                for (int r = 0; r < 4; ++r) {
                    const int j = 16 * jt + 4 * g + r;
                    float v = 0.f;
                    if (s <= j) v = a[r] * fast_exp(as - PM_[t0 + j]);
                    const unsigned short hb = (unsigned short)(cvt_pk_bf16(v, 0.f) & 0xffffu);
                    Ss[j * LDT_A + s] = hb; dsum[r] += bf2f(hb);
                }
            }
#pragma unroll
            for (int r = 0; r < 4; ++r) { float v = rowsum16(dsum[r]); if (c == 0) DENP[(16 * jt + 4 * g + r) * 2 + sp] = v; }
        }
        __syncthreads();
        f32x4 hv[4][2];
#pragma unroll
        for (int jt = 0; jt < 4; ++jt)
#pragma unroll
            for (int vt = 0; vt < 2; ++vt) hv[jt][vt] = (f32x4){0.f, 0.f, 0.f, 0.f};
#pragma unroll
        for (int ks = 0; ks < 2; ++ks) {
            const bf16x8 va0 = ldstr8(Vs, LDV_A, 32 * ks + 8 * g, 32 * wave, c, 4), va1 = ldstr8(Vs, LDV_A, 32 * ks + 8 * g, 32 * wave + 16, c, 4);
#pragma unroll
            for (int jt = 0; jt < 4; ++jt) {
                if (ks == 1 && jt < 2) continue;
                const bf16x8 sb = lds8(Ss, LDT_A, 16 * jt + c, 32 * ks + 8 * g);
                hv[jt][0] = mfma16(va0, sb, hv[jt][0]); hv[jt][1] = mfma16(va1, sb, hv[jt][1]);
            }
        }
#pragma unroll
        for (int hf = 0; hf < 2; ++hf) {
            f32x4 hq[2][2];
#pragma unroll
            for (int q = 0; q < 2; ++q)
#pragma unroll
                for (int vt = 0; vt < 2; ++vt) hq[q][vt] = (f32x4){0.f, 0.f, 0.f, 0.f};
#pragma unroll
            for (int u = 0; u < 4; ++u) {
                const bf16x8 ca0 = pack8(st[2 * u][0], st[2 * u + 1][0]), ca1 = pack8(st[2 * u][1], st[2 * u + 1][1]);
#pragma unroll
                for (int q = 0; q < 2; ++q) {
                    const bf16x8 qb = lds4x2(Qs, LDQ_A, 16 * (2 * hf + q) + c, 32 * u + 4 * g);
                    hq[q][0] = mfma16(ca0, qb, hq[q][0]); hq[q][1] = mfma16(ca1, qb, hq[q][1]);
                }
            }
#pragma unroll
            for (int q = 0; q < 2; ++q) {
                const int jt = 2 * hf + q, j = 16 * jt + c;
                const float inter = fast_exp(m_st - PM_[t0 + j]);
                const float den = DENP[2 * j] + DENP[2 * j + 1] + inter * QN[j];
                const float dd = fmaxf(fabsf(den), fast_exp(-MM_[t0 + j]));
                const float rd = 1.0f / dd;
                float sq = 0.f;
#pragma unroll
                for (int vt = 0; vt < 2; ++vt)
#pragma unroll
                    for (int r = 0; r < 4; ++r) { const float hh = (hv[jt][vt][r] + inter * hq[q][vt][r]) * rd; hv[jt][vt][r] = hh; sq += hh * hh; }
                sq = xsum16(sq); sq = xsum32(sq);
                if (g == 0) HSQ[j * 8 + wave] = sq;
            }
        }
        __syncthreads();
        {
            const f32x4 hg0 = *(const f32x4*)(hg + 32 * wave + 4 * g), hg1 = *(const f32x4*)(hg + 32 * wave + 16 + 4 * g);
#pragma unroll
            for (int jt = 0; jt < 4; ++jt) {
                const int j = 16 * jt + c;
                const f32x4 q0 = *(const LAS f32x4*)(HSQ + j * 8), q1 = *(const LAS f32x4*)(HSQ + j * 8 + 4);
                const float sq = (q0[0] + q0[1]) + (q0[2] + q0[3]) + (q1[0] + q1[1]) + (q1[2] + q1[3]);
                const float rs = 1.0f / sqrtf(sq * (1.0f / 256.0f) + EPS);
#pragma unroll
                for (int vt = 0; vt < 2; ++vt) {
                    const f32x4 gg = vt ? hg1 : hg0; const u32x2 ow = ogr[jt][vt];
                    const float y0 = hv[jt][vt][0] * rs * gg[0] * sigmoidf_(bflo(ow.x)), y1 = hv[jt][vt][1] * rs * gg[1] * sigmoidf_(bfhi(ow.x));
                    const float y2 = hv[jt][vt][2] * rs * gg[2] * sigmoidf_(bflo(ow.y)), y3 = hv[jt][vt][3] * rs * gg[3] * sigmoidf_(bfhi(ow.y));
                    u32x2 w; w.x = cvt_pk_bf16(y0, y1); w.y = cvt_pk_bf16(y2, y3);
                    *(GAS u32x2*)(Yb8 + ((row0 + j) * OUTK + h * 256 + 32 * wave + 16 * vt + 4 * g) * 2u) = w;
                }
            }
        }
        }
        const float decay = fast_exp(m_st - pm_last);
#pragma unroll
        for (int mt = 0; mt < 8; ++mt)
#pragma unroll
            for (int vt = 0; vt < 2; ++vt) st[mt][vt] *= decay;
#pragma unroll
        for (int ks = 0; ks < 2; ++ks) {
            const bf16x8 vb0 = ldstr8(Vs, LDV_A, 32 * ks + 8 * g, 32 * wave, c, 4), vb1 = ldstr8(Vs, LDV_A, 32 * ks + 8 * g, 32 * wave + 16, c, 4);
#pragma unroll
            for (int mt = 0; mt < 8; ++mt) {
                const bf16x8 ka = ldstr8(Kw, LDQ_A, 32 * ks + 8 * g, 16 * mt, c, 4);
                st[mt][0] = mfma16(ka, vb0, st[mt][0]); st[mt][1] = mfma16(ka, vb1, st[mt][1]);
            }
        }
        {
            const int d = tid & 127, part = tid >> 7; float s = 0.f;
#pragma unroll
            for (int e = 0; e < 16; ++e) s += bf2f(Kw[(16 * part + e) * LDQ_A + d]);
            NVP[part * 128 + d] = s;
        }
    }
    if constexpr (MODE == 1) {
        __syncthreads();
        float* sl = SB + (size_t)((b * 4 + h) * 3 + grp) * ML_SLOT;
        if (tid < 128) {
            const float dlast = fast_exp(MST_[ck1 - 1] - PM_[64 * ck1 - 1]);
            sl[256 * 128 + tid] = dlast * NV[tid] + ((NVP[tid] + NVP[128 + tid]) + (NVP[256 + tid] + NVP[384 + tid]));
        }
        lane = tid & 63; g = lane >> 4; c = lane & 15;
#pragma unroll
        for (int mt = 0; mt < 8; ++mt)
#pragma unroll
            for (int vt = 0; vt < 2; ++vt) *(f32x4*)(sl + (32 * wave + 16 * vt + c) * 128 + 16 * mt + 4 * g) = st[mt][vt];
    }
}

__device__ __forceinline__ void gates_phase(const int tid, const bf16_t* xb, const bf16_t* WG, const float* rss, const float* gate_b, float* gates, const int gw, const int NGW) {
    const int lane = tid & 63, g = lane >> 4, c = lane & 15;
#pragma unroll 1
    for (int t = gw; t < MTOK / 16; t += NGW) {
        const int row = 16 * t + c;
        const GAS char* xrow = (const GAS char*)xb + ((unsigned)row * DM + 8u * g) * 2u;
        const GAS char* wrow = (const GAS char*)WG + ((unsigned)c * DM + 8u * g) * 2u;
        f32x4 acc = {0.f, 0.f, 0.f, 0.f};
#pragma unroll 1
        for (int s8 = 0; s8 < 4; ++s8) {
            bf16x8 xf[8], wf[8];
#pragma unroll
            for (int q = 0; q < 8; ++q) { xf[q] = *(const GAS bf16x8*)(xrow + (unsigned)(32 * (8 * s8 + q)) * 2u); wf[q] = *(const GAS bf16x8*)(wrow + (unsigned)(32 * (8 * s8 + q)) * 2u); }
#pragma unroll
            for (int q = 0; q < 8; ++q) acc = mfma16(wf[q], xf[q], acc);
        }
        const GAS f32x4* rp = (const GAS f32x4*)((const GAS char*)rss + (unsigned)row * 64u);
        const f32x4 tt = (rp[0] + rp[1]) + (rp[2] + rp[3]);
        const float rs = __builtin_amdgcn_rsqf(((tt[0] + tt[1]) + (tt[2] + tt[3])) * (1.0f / 1024.0f) + EPS);
        if (g < 2) {
            const f32x4 bb = *(const f32x4*)(gate_b + 4 * g);
            f32x4 o;
#pragma unroll
            for (int r = 0; r < 4; ++r) { const float x = acc[r] * rs + bb[r]; o[r] = (g == 0) ? x : (fminf(x, 0.f) - 0.693147180559945f * __builtin_amdgcn_logf(1.0f + fast_exp(-fabsf(x)))); }
            *(f32x4*)(gates + (size_t)row * 8 + 4 * g) = o;
        }
    }
}

#define XB_TMO      128
#define XB_XCNT(j)  (256  + 64 * (j))
#define XB_XSUB(j)  (1280 + 64 * (j))
#define XB_XGEN(j)  (2304 + 64 * (j))
#define XB_TOP      3328
#define XB_TOPGEN   3392
#define XB_SPIN_CAP (1u << 22)
__device__ __forceinline__ unsigned xb_ld(unsigned* p)              { return __hip_atomic_load(p, __ATOMIC_RELAXED, __HIP_MEMORY_SCOPE_AGENT); }
__device__ __forceinline__ unsigned xb_add(unsigned* p, unsigned v) { return __hip_atomic_fetch_add(p, v, __ATOMIC_RELAXED, __HIP_MEMORY_SCOPE_AGENT); }
__device__ __forceinline__ unsigned xb_xcc_id() { return (unsigned)__builtin_amdgcn_s_getreg((3 << 11) | 20) & 0xFu; }
#define XB_SPIN(cond, bar) do { unsigned _sp = 0; while (cond) { __builtin_amdgcn_s_sleep(1); \
    if ((++_sp & 255u) == 0u) { if (xb_ld(&(bar)[XB_TMO])) break; if (_sp > XB_SPIN_CAP) { atomicAdd(&(bar)[XB_TMO], 1u); break; } } } } while (0)
__device__ __forceinline__ void xcd_barrier_complete(unsigned* bar, unsigned x, unsigned& nloc, unsigned& nx) {
    const unsigned G = gridDim.x;
    unsigned sum, cnt, mine, sp = 0u;
    for (;;) {
        sum = 0u; cnt = 0u; mine = 0u;
#pragma unroll
        for (unsigned j = 0; j < 16; ++j) { const unsigned c = xb_ld(&bar[XB_XCNT(j)]); sum += c; cnt += (c > 0u) ? 1u : 0u; mine = (j == x) ? c : mine; }
        if (sum == G) break;
        __builtin_amdgcn_s_sleep(1);
        if ((++sp & 255u) == 0u) { if (xb_ld(&bar[XB_TMO])) break; if (sp > XB_SPIN_CAP) { atomicAdd(&bar[XB_TMO], 1u); break; } }
    }
    nloc = mine > 0u ? mine : 1u; nx = cnt > 0u ? cnt : 1u;
}
__device__ __forceinline__ void xcd_barrier(const int tid, unsigned* bar, volatile LAS unsigned* st) {
    asm volatile("s_waitcnt vmcnt(0)" ::: "memory");
    __syncthreads();
    if (tid == 0) {
        const unsigned x = xb_xcc_id();
        __builtin_amdgcn_s_waitcnt(0);
        unsigned nloc = st[0], nx = st[1];
        if (nloc == 0u) { xcd_barrier_complete(bar, x, nloc, nx); st[0] = nloc; st[1] = nx; }
        const unsigned old = xb_add(&bar[XB_XSUB(x)], 1u);
        const unsigned gen = old / nloc;
        if (old + 1u == (gen + 1u) * nloc) {
            __builtin_amdgcn_fence(__ATOMIC_RELEASE, "agent");
            asm volatile("s_waitcnt vmcnt(0)" ::: "memory");
            const unsigned og = xb_add(&bar[XB_TOP], 1u);
            const unsigned tg = og / nx;
            if (og + 1u == (tg + 1u) * nx) xb_add(&bar[XB_TOPGEN], 1u);
            else XB_SPIN(xb_ld(&bar[XB_TOPGEN]) == tg, bar);
            __builtin_amdgcn_fence(__ATOMIC_ACQUIRE, "agent");
            xb_add(&bar[XB_XGEN(x)], 1u);
            asm volatile("s_waitcnt vmcnt(0)" ::: "memory");
        } else {
            XB_SPIN(xb_ld(&bar[XB_XGEN(x)]) == gen, bar);
            __builtin_amdgcn_fence(__ATOMIC_ACQUIRE, "agent");
            asm volatile("s_waitcnt vmcnt(0)" ::: "memory");
        }
    }
    __syncthreads();
}

__global__ void __launch_bounds__(NTHREADS, 2) mega(Params p) {
    extern __shared__ __attribute__((aligned(16))) unsigned char smem[];
    LAS unsigned char* lds = (LAS unsigned char*)smem;
    const int G = gridDim.x, bid = blockIdx.x;
    const int wave_id = __builtin_amdgcn_readfirstlane((int)(threadIdx.x >> 6));
    volatile LAS unsigned* bst = (volatile LAS unsigned*)(lds + LDS_BYTES - 16);
    if (threadIdx.x == 0) {
#pragma unroll
        for (int k2 = 0; k2 < 23; ++k2) { const unsigned long long a = (unsigned long long)p.in[k2]; u32x2 w; w.x = (unsigned)a; w.y = (unsigned)(a >> 32); *(LAS u32x2*)(lds + LDS_PTRS + 8 * k2) = w; }
    }
    if (threadIdx.x == 0) { bst[0] = 0u; bst[1] = 0u; (void)xb_add(&((unsigned*)(p.ws + WS_BAR))[XB_XCNT(xb_xcc_id())], 1u); }
    __syncthreads();
#pragma unroll 1
    for (int s = p.ph_lo; s < p.ph_hi; ++s) {
#define FRESH_TID(v) do { asm volatile("v_mbcnt_lo_u32_b32 %0, -1, 0\n\tv_mbcnt_hi_u32_b32 %0, -1, %0" : "=v"(v)); v += wave_id * 64; } while (0)
        int tid; FRESH_TID(tid);
        unsigned char* ws = p.ws; asm volatile("" : "+s"(ws));
        if (p.ph_lo < 0) cg::this_grid().sync();
        if (s > p.ph_lo) xcd_barrier(tid, (unsigned*)(ws + WS_BAR), bst);
        bf16_t* xb = (bf16_t*)(ws + WS_XB); bf16_t* Hb = (bf16_t*)(ws + WS_H); bf16_t* Yb = (bf16_t*)p.out; unsigned char* xlo = ws + WS_Y;
        float* rss = (float*)(ws + WS_RSS); float* gates = (float*)(ws + WS_GATES);
        const int L = (s == 0) ? 0 : (s - 1) / 7, k = (s == 0) ? 0 : (s - 1) % 7 + 1, j = L >> 1; const bool isA = (L & 1) == 0;
        unsigned char* wsl = ws + ((L & 1) ? WS_SET1 : (size_t)0);
        if (k == 0) {
            FRESH_TID(tid);
            convert_phase(tid, p, ws, 0, lds, bid * 8 + (tid >> 6), G * 8, true);
        } else if (k == 1 || k == 6) {
            FRESH_TID(tid);
            if (L == 0 && k == 1) {
                pg8::Gemm g{(const bf16_t*)(ws + WS_MEMB), (const bf16_t*)(ws + WS_MEMW), MROWS, 1024, DM}; pg8::StaticOrder S; S.init(MROWS, 1024, G, bid);
                pg8::EpiMemKV E{(const float*)(ws + WS_MEMRS), (bf16_t*)(ws + WS_MEMK), (bf16_t*)(ws + WS_MEMVT), nullptr};
                pg8::gemm_phase<pg8::EpiMemKV>(tid, lds, g, S, E);
            }
            FRESH_TID(tid);
            pg8::Gemm g{xb, (const bf16_t*)(wsl + (k == 1 ? WS_WIN0 : WS_WIN1)), MTOK, 2 * DFF, DM}; pg8::StaticOrder S; S.init(MTOK, 2 * DFF, G, bid);
            pg8::EpiSwiglu E{rss, Hb};
            pg8::gemm_phase<pg8::EpiSwiglu>(tid, lds, g, S, E);

        } else if (k == 2 || k == 5 || k == 7) {
            FRESH_TID(tid);
            const bf16_t* A = (k == 5) ? Yb : Hb; const int K = (k == 5) ? OUTK : DFF;
            const bf16_t* W = (const bf16_t*)(wsl + (k == 2 ? WS_WOUT0 : (k == 5 ? WS_MOUT : WS_WOUT1)));
            pg8::Gemm g{A, W, MTOK, DM, K}; pg8::StaticOrder S; S.init(MTOK, DM, G, bid);
            pg8::EpiResid E{(L == DEPTH - 1 && k == 7) ? p.out : nullptr, xb, xlo, rss};
            pg8::gemm_phase<pg8::EpiResid>(tid, lds, g, S, E);
        } else if (k == 3) {
            FRESH_TID(tid);
            const int N = isA ? A_LDP : B_INW;
            pg8::Gemm g{xb, (const bf16_t*)(wsl + WS_MIN), MTOK, N, DM}; pg8::StaticOrder S; S.init(MTOK, N, G, bid);
            pg8::EpiProj E{rss, Hb, N};
            pg8::gemm_phase<pg8::EpiProj>(tid, lds, g, S, E);
            if (isA) { FRESH_TID(tid); gates_phase(tid, xb, (const bf16_t*)(wsl + WS_WG), rss, INP(15) + j * 8, gates, bid * 8 + (tid >> 6), G * 8); }
        } else {
            FRESH_TID(tid);
            if (isA) {
                for (int it = bid; it < 192; it += G) { FRESH_TID(tid); mlstm_item<1>(tid, p, ws, j, it / 3, it % 3, Hb, Yb, lds); }
                FRESH_TID(tid);
                for (int it = bid; it < 512; it += G) mem_attn_item(tid, p, ws, L, it, Hb, A_LDP, 3072, Yb, lds);
                if (L + 1 < DEPTH) { __syncthreads(); convert_phase(tid, p, ws, L + 1, lds, bid * 8 + (tid >> 6), G * 8, false); }
                xcd_barrier(tid, (unsigned*)(ws + WS_BAR), bst);
                FRESH_TID(tid);
                for (int it = bid; it < 256; it += G) { FRESH_TID(tid); mlstm_item<2>(tid, p, ws, j, it >> 2, it & 3, Hb, Yb, lds); }
            } else {
                for (int it = bid; it < 512; it += G) swa_item(tid, p, ws, j, it, Hb, Yb, lds);
                for (int it = bid; it < 512; it += G) mem_attn_item(tid, p, ws, L, it, Hb, B_INW, 1280, Yb, lds);
                if (L + 1 < DEPTH) { __syncthreads(); convert_phase(tid, p, ws, L + 1, lds, bid * 8 + (tid >> 6), G * 8, false); }
            }
        }
    }
}

extern "C" void kernel_launch(void* const* d_in, const int* in_sizes, int n_in, void* d_out, int out_size, void* d_ws, size_t ws_size, hipStream_t stream) {
    static int grid = 0;
    if (grid == 0) {
        int dev = 0, cus = 0, per_cu = 0;
        hipGetDevice(&dev);
        hipDeviceGetAttribute(&cus, hipDeviceAttributeMultiprocessorCount, dev);
        if (hipFuncSetAttribute((const void*)mega, hipFuncAttributeMaxDynamicSharedMemorySize, LDS_BYTES) != hipSuccess) { fprintf(stderr, "kernel_launch: hipFuncSetAttribute failed\n"); grid = -1; return; }
        hipOccupancyMaxActiveBlocksPerMultiprocessor(&per_cu, (const void*)mega, NTHREADS, LDS_BYTES);
        if (per_cu < 1) { fprintf(stderr, "kernel_launch: occupancy query says %d blocks per CU\n", per_cu); per_cu = 1; }
        (void)hipGetLastError();
        grid = cus * 1;
        if (n_in != 23 || ws_size < WS_END) { fprintf(stderr, "kernel_launch: unexpected n_in %d / ws %zu (need %zu)\n", n_in, ws_size, (size_t)WS_END); grid = -1; return; }
    }
    if (grid < 0) return;
    Params p{};
    for (int i = 0; i < 23; ++i) p.in[i] = (const float*)d_in[i];
    p.out = (float*)d_out; p.ws = (unsigned char*)d_ws;
    p.ph_lo = 0; p.ph_hi = 1 + 7 * DEPTH;
    if (hipMemsetAsync((char*)d_ws + WS_BAR, 0, (size_t)XCD_BAR_WORDS_C * 4, stream) != hipSuccess) { fprintf(stderr, "kernel_launch: memset of barrier words failed\n"); return; }
    void* args[] = {&p};
    hipError_t e = hipLaunchCooperativeKernel((const void*)mega, dim3(grid), dim3(NTHREADS), args, LDS_BYTES, stream);
    if (e != hipSuccess) fprintf(stderr, "cooperative launch failed: %s (grid %d)\n", hipGetErrorString(e), grid);
}
```

```cpp
#include <hip/hip_runtime.h>
#include <hip/hip_cooperative_groups.h>
#include <cstdio>
#include <cmath>
namespace cg = cooperative_groups;

#define LAS __attribute__((address_space(3)))
#define GAS __attribute__((address_space(1)))
typedef unsigned short bf16_t;
typedef short bf16x8 __attribute__((ext_vector_type(8)));
typedef short bf16x4 __attribute__((ext_vector_type(4)));
typedef float f32x4 __attribute__((ext_vector_type(4)));
typedef unsigned u32x4 __attribute__((ext_vector_type(4)));
typedef unsigned u32x2 __attribute__((ext_vector_type(2)));

constexpr int DM = 1024, NB = 16, SEQ = 2048, MTOK = NB * SEQ, DFF = 2816, DEPTH = 4;
constexpr int A_INW = 3592, A_NPAD = 3840, A_LDP = 3584, B_INW = 1792, OUTK = 1536;
constexpr int NMEM = 256, MROWS = NB * NMEM;
constexpr float EPS = 1e-6f;
constexpr int NTHREADS = 512;
constexpr int LDS_BYTES = 148 * 1024;
constexpr int XCD_BAR_WORDS_C = 3456;
#ifndef SPL
#define SPL 8
#define STEP_TABLE 0x76543210ull
#endif

constexpr size_t al256(size_t x) { return (x + 255) & ~(size_t)255; }
constexpr size_t WS_WIN0 = 0;
constexpr size_t WS_WIN1 = WS_WIN0 + al256((size_t)2 * DFF * DM * 2);
constexpr size_t WS_WOUT0 = WS_WIN1 + al256((size_t)2 * DFF * DM * 2);
constexpr size_t WS_WOUT1 = WS_WOUT0 + al256((size_t)DM * DFF * 2);
constexpr size_t WS_MIN = WS_WOUT1 + al256((size_t)DM * DFF * 2);
constexpr size_t WS_MOUT = WS_MIN + al256((size_t)A_NPAD * DM * 2);
constexpr size_t WS_WG = WS_MOUT + al256((size_t)DM * OUTK * 2);
constexpr size_t WS_MEMW = WS_WG + al256((size_t)16 * DM * 2);
constexpr size_t WS_MEMB = WS_MEMW + al256((size_t)1024 * DM * 2);
constexpr size_t WS_MEMK = WS_MEMB + al256((size_t)MROWS * DM * 2);
constexpr size_t WS_MEMVT = WS_MEMK + al256((size_t)MROWS * 512 * 2);
constexpr size_t WS_MEMRS = WS_MEMVT + al256((size_t)MROWS * 512 * 2);
constexpr size_t WS_XB = WS_MEMRS + al256((size_t)MROWS * 4);
constexpr size_t WS_H = WS_XB + al256((size_t)MTOK * DM * 2);
constexpr size_t WS_Y = WS_H + al256((size_t)MTOK * A_LDP * 2);
constexpr size_t WS_GATES = WS_Y + al256((size_t)MTOK * OUTK * 2);
constexpr size_t WS_RSS = WS_GATES + al256((size_t)MTOK * 8 * 4);
constexpr size_t WS_ROPE = WS_RSS + al256((size_t)16 * MTOK * 4);
constexpr size_t WS_BAR = WS_ROPE + al256((size_t)MTOK * 16 * 4);
constexpr size_t WS_SET1 = WS_BAR + al256((size_t)XCD_BAR_WORDS_C * 4);
constexpr size_t WS_END = WS_SET1 + WS_MEMW;

struct Params {
    const float* in[23];
    float* out;
    unsigned char* ws;
    int ph_lo, ph_hi;
};

typedef float f32x2 __attribute__((ext_vector_type(2)));
typedef __bf16 bf16x2_t __attribute__((ext_vector_type(2)));
__device__ __forceinline__ unsigned cvt_pk_bf16(float lo, float hi) { const f32x2 v = {lo, hi}; return __builtin_bit_cast(unsigned, __builtin_convertvector(v, bf16x2_t)); }
__device__ __forceinline__ unsigned cvt_pk_bf16(f32x2 v) { return __builtin_bit_cast(unsigned, __builtin_convertvector(v, bf16x2_t)); }
__device__ __forceinline__ float bf2f(unsigned short h) { return __uint_as_float(((unsigned)h) << 16); }
__device__ __forceinline__ float bflo(unsigned w) { return __uint_as_float(w << 16); }
__device__ __forceinline__ float bfhi(unsigned w) { return __uint_as_float(w & 0xffff0000u); }
__device__ __forceinline__ f32x4 mfma16(bf16x8 a, bf16x8 b, f32x4 c) { return __builtin_amdgcn_mfma_f32_16x16x32_bf16(a, b, c, 0, 0, 0); }
__device__ __forceinline__ bf16x8 pack8(f32x4 a, f32x4 b) {
    u32x4 t; t.x = cvt_pk_bf16(a[0], a[1]); t.y = cvt_pk_bf16(a[2], a[3]); t.z = cvt_pk_bf16(b[0], b[1]); t.w = cvt_pk_bf16(b[2], b[3]);
    return __builtin_bit_cast(bf16x8, t);
}
__device__ __forceinline__ bf16x8 lds8(const LAS bf16_t* base, int ld, int row, int col) { return *(const LAS bf16x8*)(base + row * ld + col); }
__device__ __forceinline__ bf16x8 lds4x2(const LAS bf16_t* base, int ld, int row, int col) {
    const u32x2 a = *(const LAS u32x2*)(base + row * ld + col), b = *(const LAS u32x2*)(base + row * ld + col + 16);
    u32x4 t; t.x = a.x; t.y = a.y; t.z = b.x; t.w = b.y; return __builtin_bit_cast(bf16x8, t);
}
__device__ __forceinline__ float xsum16(float v) { const auto r = __builtin_amdgcn_permlane16_swap(__float_as_uint(v), __float_as_uint(v), false, false); return __uint_as_float(r[0]) + __uint_as_float(r[1]); }
__device__ __forceinline__ float xsum32(float v) { const auto r = __builtin_amdgcn_permlane32_swap(__float_as_uint(v), __float_as_uint(v), false, false); return __uint_as_float(r[0]) + __uint_as_float(r[1]); }
__device__ __forceinline__ float xmax16(float v) { const auto r = __builtin_amdgcn_permlane16_swap(__float_as_uint(v), __float_as_uint(v), false, false); return fmaxf(__uint_as_float(r[0]), __uint_as_float(r[1])); }
__device__ __forceinline__ float xmax32(float v) { const auto r = __builtin_amdgcn_permlane32_swap(__float_as_uint(v), __float_as_uint(v), false, false); return fmaxf(__uint_as_float(r[0]), __uint_as_float(r[1])); }
__device__ __forceinline__ float shfl_from(float v, int srclane) { return __int_as_float(__builtin_amdgcn_ds_bpermute(srclane << 2, __float_as_int(v))); }
__device__ __forceinline__ float dpp_x1(float v) { return __int_as_float(__builtin_amdgcn_update_dpp(0, __float_as_int(v), 0xB1, 0xf, 0xf, true)); }
__device__ __forceinline__ float rowsum4(float v) { v += dpp_x1(v); v += __int_as_float(__builtin_amdgcn_update_dpp(0, __float_as_int(v), 0x4E, 0xf, 0xf, true)); return v; }
__device__ __forceinline__ float rowsum8(float v) { v = rowsum4(v); v += __int_as_float(__builtin_amdgcn_update_dpp(0, __float_as_int(v), 0x141, 0xf, 0xf, true)); return v; }
__device__ __forceinline__ float rowsum16(float v) { v = rowsum8(v); v += __int_as_float(__builtin_amdgcn_update_dpp(0, __float_as_int(v), 0x140, 0xf, 0xf, true)); return v; }
__device__ __forceinline__ float wave_sum(float v) {
    v = rowsum16(v); v = xsum16(v); v = xsum32(v);
    return v;
}
__device__ __forceinline__ float fast_exp(float x) { return __builtin_amdgcn_exp2f(x * 1.44269504088896341f); }
__device__ __forceinline__ float sigmoidf_(float x) { return __builtin_amdgcn_rcpf(1.0f + fast_exp(-x)); }
__device__ __forceinline__ int perm32(int rho) { const int n = rho >> 4, i = rho & 15; return 8 * (i >> 2) + 4 * n + (i & 3); }

constexpr int LDS_PTRS = LDS_BYTES - 304;
__device__ __forceinline__ const float* ld_inptr(LAS unsigned char* lds, int k) {
    const u32x2 v = *(const LAS u32x2*)(lds + LDS_PTRS + 8 * k);
    const unsigned lo = __builtin_amdgcn_readfirstlane(v.x), hi = __builtin_amdgcn_readfirstlane(v.y);
    return (const float*)(((unsigned long long)hi << 32) | (unsigned long long)lo);
}
#define INP(k) ld_inptr(lds, k)
namespace pg8 {
constexpr int BM = 256, BK = 64, HALF = 128, HTB = HALF * BK * 2, STAGE_BYTES = 8 * HTB, NXCD = 8, WGM = 8;
__device__ __forceinline__ int lds_byte(int r, int c) { const int st = (r >> 4) * 2 + (c >> 5), rr = r & 15, cc = c & 31, ob = rr * 64 + cc * 2; return st * 1024 + (ob ^ (((ob >> 9) & 1) << 5)); }
__device__ __forceinline__ void stage_rc(int b, int& R, int& C) { const int st = b / 1024, sb = b % 1024, swz = sb ^ (((sb >> 9) & 1) << 5); R = (st >> 1) * 16 + swz / 64; C = (st & 1) * 32 + (swz % 64) / 2; }
struct Unit { int pm, pn; };
struct Gemm { const bf16_t* A; const bf16_t* Bt; int M, N, K; };
struct StaticOrder {
    int nM, nN, nwg, G, c;
    __device__ void init(int M, int N, int G_, int c_) { nM = M / BM; nN = N / BM; nwg = nM * nN; G = G_; c = c_; }
    __device__ bool next(int i, Unit& u) const {
        const long L = (long)i * G + c; if (L >= nwg) return false;
        int wgid = (int)L; { const int q = nwg / NXCD, r = nwg % NXCD, xcd = wgid % NXCD, off = wgid / NXCD; wgid = (xcd < r ? xcd * (q + 1) : r * (q + 1) + (xcd - r) * q) + off; }
        const int nig = WGM * nN, gid = wgid / nig, fm = gid * WGM, gsz = (nM - fm) < WGM ? (nM - fm) : WGM;
        u.pm = fm + ((wgid % nig) % gsz); u.pn = (wgid % nig) / gsz; return true;
    }
};

__device__ __forceinline__ void row_rs8(const float* rss, int row0, int fq, float (&rsv)[2][4]) {
    float ps[2][4];
#pragma unroll
    for (int ai = 0; ai < 2; ++ai)
#pragma unroll
        for (int m = 0; m < 4; ++m) {
            const f32x4 q = *(const f32x4*)(rss + (size_t)(row0 + ai * HALF + m * 16) * 16 + 4 * fq);
            ps[ai][m] = (q[0] + q[1]) + (q[2] + q[3]);
        }
#pragma unroll
    for (int ai = 0; ai < 2; ++ai)
#pragma unroll
        for (int m = 0; m < 4; ++m) {
            float s = ps[ai][m];
            s = xsum16(s); s = xsum32(s);
            rsv[ai][m] = 1.0f / sqrtf(s * (1.0f / 1024.0f) + EPS);
        }
}

constexpr int RS2_OFF = STAGE_BYTES + 16384;
__device__ __forceinline__ void rs_finalize(LAS unsigned char* lds, int wid) {
    if (wid < 4) {
        int l2; asm volatile("v_mbcnt_lo_u32_b32 %0, -1, 0\n\tv_mbcnt_hi_u32_b32 %0, -1, %0" : "=v"(l2));
        const int row = wid * 64 + l2;
        const LAS f32x4* q = (const LAS f32x4*)(lds + STAGE_BYTES) + row * 4;
        const f32x4 t = (q[0] + q[1]) + (q[2] + q[3]);
        const float rs = __builtin_amdgcn_rsqf(((t[0] + t[1]) + (t[2] + t[3])) * (1.0f / 1024.0f) + EPS);
        f32x2 o; o.x = rs; o.y = rs * rs;
        *(LAS f32x2*)(lds + RS2_OFF + row * 8) = o;
    }
}
__device__ __forceinline__ void row_rs8_lds(LAS unsigned char* lds, int wr, int fr, int fq, float (&rsv)[2][4]) {
#pragma unroll
    for (int ai = 0; ai < 2; ++ai)
#pragma unroll
        for (int m = 0; m < 4; ++m) rsv[ai][m] = (*(const LAS f32x2*)(lds + RS2_OFF + (ai * HALF + wr * 64 + m * 16 + fr) * 8)).x;
}

struct EpiSwiglu {
    static constexpr bool RS_LDS = true;
    const float* rss; bf16_t* H;
    __device__ __forceinline__ void operator()(f32x4 (&acc)[2][2][4][2], const Unit& u, int wr, int wc, int fr, int fq, LAS unsigned char* lds) const {
        const int row0 = u.pm * BM + wr * 64 + fr, j0 = u.pn * 128 + wc * 32 + fq * 8;
        float rsv[2][4]; row_rs8_lds(lds, wr, fr, fq, rsv);
#pragma unroll
        for (int ai = 0; ai < 2; ++ai)
#pragma unroll
            for (int m = 0; m < 4; ++m) {
                const int row = row0 + ai * HALF + m * 16;
                const float rs = rsv[ai][m], nrs = rs * -1.44269504088896341f, rs2 = rs * rs;
                unsigned w[4];
#pragma unroll
                for (int n = 0; n < 2; ++n)
#pragma unroll
                    for (int hp = 0; hp < 2; ++hp) {
                        const f32x2 g = {acc[ai][0][m][n][2 * hp], acc[ai][0][m][n][2 * hp + 1]}, up = {acc[ai][1][m][n][2 * hp], acc[ai][1][m][n][2 * hp + 1]};
                        const f32x2 t = g * nrs;
                        f32x2 d; d.x = __builtin_amdgcn_exp2f(t.x); d.y = __builtin_amdgcn_exp2f(t.y);
                        d = d + 1.0f;
                        f32x2 r; r.x = __builtin_amdgcn_rcpf(d.x); r.y = __builtin_amdgcn_rcpf(d.y);
                        const f32x2 hh = ((g * up) * rs2) * r;
                        w[2 * n + hp] = cvt_pk_bf16(hh);
                    }
                u32x4 wv; wv.x = w[0]; wv.y = w[1]; wv.z = w[2]; wv.w = w[3];
                *(u32x4*)(H + (size_t)row * DFF + j0) = wv;
            }
    }
};
__device__ __forceinline__ f32x2 xdec2(unsigned w, float b0, float b1) {
    const unsigned h0 = w << 16, h1 = w & 0xffff0000u;
    const float u0 = __uint_as_float(h0 & 0x7f800000u), u1 = __uint_as_float(h1 & 0x7f800000u);
    f32x2 r;
    r.x = fmaf(fmaf(b0, 0x1p-15f, -0x1p-8f), u0, __uint_as_float(h0));
    r.y = fmaf(fmaf(b1, 0x1p-15f, -0x1p-8f), u1, __uint_as_float(h1));
    return r;
}
__device__ __forceinline__ unsigned xenc2(float x0, float x1, unsigned& w) {
    w = cvt_pk_bf16(x0, x1);
    const unsigned h0 = w << 16, h1 = w & 0xffff0000u;
    const unsigned s0 = 0x86800000u - (h0 & 0x7f800000u), s1 = 0x86800000u - (h1 & 0x7f800000u);
    const float q0 = fmaf(x0 - __uint_as_float(h0), __uint_as_float(s0 < 0x7f000000u ? s0 : 0x7f000000u), 128.5f);
    const float q1 = fmaf(x1 - __uint_as_float(h1), __uint_as_float(s1 < 0x7f000000u ? s1 : 0x7f000000u), 128.5f);
    unsigned r = __builtin_amdgcn_cvt_pk_u8_f32(q0, 0u, 0u);
    r = __builtin_amdgcn_cvt_pk_u8_f32(q1, 1u, r);
    return r;
}
struct EpiResid {
    static constexpr bool RS_LDS = false;
    float* xout_f32; bf16_t* xb; unsigned char* xlo; float* rss;
    __device__ __forceinline__ void operator()(f32x4 (&acc)[2][2][4][2], const Unit& u, int wr, int wc, int fr, int fq, LAS unsigned char* lds) const {
        const int row0 = u.pm * BM + wr * 64 + fr, c0 = u.pn * BM + wc * 32 + fq * 8;
        const unsigned e0 = (unsigned)(row0 * DM + c0);
        {
#pragma unroll
            for (int ai = 0; ai < 2; ++ai) {
                u32x4 hh[4][2];
#pragma unroll
                for (int m = 0; m < 4; ++m)
#pragma unroll
                    for (int bj = 0; bj < 2; ++bj) {
                        const unsigned off = e0 + (unsigned)((ai * HALF + m * 16) * DM + bj * HALF);
                        hh[m][bj] = *(const GAS u32x4*)((const GAS char*)xb + 2u * off);
                    }
#pragma unroll
                for (int m = 0; m < 4; ++m)
#pragma unroll
                    for (int bj = 0; bj < 2; ++bj) {
                        const u32x4 hw = hh[m][bj];
                        acc[ai][bj][m][0] += (f32x4){bflo(hw.x), bfhi(hw.x), bflo(hw.y), bfhi(hw.y)}; acc[ai][bj][m][1] += (f32x4){bflo(hw.z), bfhi(hw.z), bflo(hw.w), bfhi(hw.w)};
                    }
                __builtin_amdgcn_sched_barrier(0);
            }
        }
        unsigned e1 = e0; asm volatile("" : "+v"(e1));
#pragma unroll
        for (int ai = 0; ai < 2; ++ai)
#pragma unroll
            for (int m = 0; m < 4; ++m) {
                const int row = row0 + ai * HALF + m * 16; float ss = 0.f;
#pragma unroll
                for (int bj = 0; bj < 2; ++bj) {
                    const unsigned off = e1 + (unsigned)((ai * HALF + m * 16) * DM + bj * HALF);
                    const f32x4 o0 = acc[ai][bj][m][0], o1 = acc[ai][bj][m][1];
                    u32x4 hw; hw.x = cvt_pk_bf16(o0[0], o0[1]); hw.y = cvt_pk_bf16(o0[2], o0[3]); hw.z = cvt_pk_bf16(o1[0], o1[1]); hw.w = cvt_pk_bf16(o1[2], o1[3]);
                    *(GAS u32x4*)((GAS char*)xb + 2u * off) = hw;
                    if (xout_f32) { *(GAS f32x4*)((GAS char*)xout_f32 + 4u * off) = o0; *(GAS f32x4*)((GAS char*)xout_f32 + 4u * off + 16u) = o1; }
                    ss += o0[0] * o0[0] + o0[1] * o0[1] + o0[2] * o0[2] + o0[3] * o0[3] + o1[0] * o1[0] + o1[1] * o1[1] + o1[2] * o1[2] + o1[3] * o1[3];
                }
                ss = xsum16(ss); ss = xsum32(ss);
                if (fq == 0) rss[(size_t)row * 16 + u.pn * 4 + wc] = ss;
            }
    }
};
struct EpiProj {
    static constexpr bool RS_LDS = true;
    const float* rss; bf16_t* P; int ldp;
    __device__ __forceinline__ void operator()(f32x4 (&acc)[2][2][4][2], const Unit& u, int wr, int wc, int fr, int fq, LAS unsigned char* lds) const {
        const int row0 = u.pm * BM + wr * 64 + fr, c0 = u.pn * BM + wc * 32 + fq * 8;
        float rsv[2][4]; row_rs8_lds(lds, wr, fr, fq, rsv);
        {
#pragma unroll
            for (int ai = 0; ai < 2; ++ai)
#pragma unroll
                for (int m = 0; m < 4; ++m) {
                    const int row = row0 + ai * HALF + m * 16; const float rs = rsv[ai][m];
#pragma unroll
                    for (int bj = 0; bj < 2; ++bj) {
                        const f32x4 v0 = acc[ai][bj][m][0] * rs, v1 = acc[ai][bj][m][1] * rs;
                        u32x4 w; w.x = cvt_pk_bf16(v0[0], v0[1]); w.y = cvt_pk_bf16(v0[2], v0[3]); w.z = cvt_pk_bf16(v1[0], v1[1]); w.w = cvt_pk_bf16(v1[2], v1[3]);
                        *(u32x4*)(P + (size_t)row * ldp + c0 + bj * HALF) = w;
                    }
                }
        }
    }
};
struct EpiMemKV {
    static constexpr bool RS_LDS = false;
    const float* mrs; bf16_t* MK; bf16_t* MVT; const float* rss;
    __device__ __forceinline__ void operator()(f32x4 (&acc)[2][2][4][2], const Unit& u, int wr, int wc, int fr, int fq, LAS unsigned char* lds) const {
        const int row0 = u.pm * BM + wr * 64 + fr, c0 = u.pn * BM + wc * 32 + fq * 8;
        float rsv[2][4];
#pragma unroll
        for (int ai = 0; ai < 2; ++ai)
#pragma unroll
            for (int m = 0; m < 4; ++m) rsv[ai][m] = mrs[row0 + ai * HALF + m * 16];
#pragma unroll
        for (int ai = 0; ai < 2; ++ai)
#pragma unroll
            for (int m = 0; m < 4; ++m) {
                const int row = row0 + ai * HALF + m * 16;
                const float rs = rsv[ai][m];
#pragma unroll
                for (int bj = 0; bj < 2; ++bj) {
                    const f32x4 v0 = acc[ai][bj][m][0] * rs, v1 = acc[ai][bj][m][1] * rs;
                    const int c = c0 + bj * HALF;
                    if (u.pn < 2) {
                        u32x4 w; w.x = cvt_pk_bf16(v0[0], v0[1]); w.y = cvt_pk_bf16(v0[2], v0[3]); w.z = cvt_pk_bf16(v1[0], v1[1]); w.w = cvt_pk_bf16(v1[2], v1[3]);
                        *(u32x4*)(MK + (size_t)row * 512 + c) = w;
                    } else {
                        const int cv = c - 512, hh = cv >> 7, dv = cv & 127, bb = row >> 8, mm = row & 255;
                        bf16_t* dst = MVT + ((size_t)(bb * 4 + hh) * 128 + dv) * 256 + mm;
#pragma unroll
                        for (int e = 0; e < 4; ++e) { dst[(size_t)e * 256] = (bf16_t)(cvt_pk_bf16(v0[e], 0.f) & 0xffffu); dst[(size_t)(4 + e) * 256] = (bf16_t)(cvt_pk_bf16(v1[e], 0.f) & 0xffffu); }
                    }
                }
            }
    }
};

template <class Epi>
__device__ __forceinline__ void gemm_phase(const int tid, LAS unsigned char* lds, const Gemm g, const StaticOrder& S, const Epi& E) {
    const int wid = __builtin_amdgcn_readfirstlane(tid >> 6), lane = tid & 63, wr = wid >> 2, wc = wid & 3, fr = lane & 15, fq = lane >> 4;
    const int K = g.K, nt = K / BK;
    unsigned voffA[2];
#pragma unroll
    for (int i = 0; i < 2; ++i) { int R, C; stage_rc(tid * 16 + i * 8192, R, C); voffA[i] = (unsigned)(R * K + C) * 2u; }
    const size_t kstep = (size_t)(BK * 2);
    const size_t hstep = (size_t)HALF * K * 2;
    const size_t tstep = 2 * hstep;
    const unsigned ldsw = (unsigned)wid * 1024u;
    const int aoff = lds_byte(wr * 64 + fr, fq * 8), boff = lds_byte(wc * 32 + fr, fq * 8);
#define PG8_SA(b, h) (((b) * 2 + (h)) * HTB)
#define PG8_SB(b, h) ((4 + (b) * 2 + (h)) * HTB)
#define PG8_STAGE(bufoff, gbase) do { _Pragma("unroll") for (int _i = 0; _i < 2; ++_i) \
        __builtin_amdgcn_global_load_lds((const unsigned*)((const char*)(gbase) + voffA[_i]), (LAS unsigned*)(lds + (bufoff) + ldsw + _i * 8192), 16, 0, 0); } while (0)
#define PG8_LDA(dst, b, h) do { _Pragma("unroll") for (int m = 0; m < 4; ++m) _Pragma("unroll") for (int k = 0; k < 2; ++k) dst[m][k] = *(const LAS bf16x8*)(lds + PG8_SA(b, h) + aoff + m * 2048 + k * 1024); } while (0)
#define PG8_LDB(dst, b, h) do { _Pragma("unroll") for (int n = 0; n < 2; ++n) _Pragma("unroll") for (int k = 0; k < 2; ++k) dst[n][k] = *(const LAS bf16x8*)(lds + PG8_SB(b, h) + boff + n * 2048 + k * 1024); } while (0)
#define PG8_MMA(ai, bj, At, Bt) do { __builtin_amdgcn_s_setprio(1); _Pragma("unroll") for (int m = 0; m < 4; ++m) _Pragma("unroll") for (int n = 0; n < 2; ++n) _Pragma("unroll") for (int k = 0; k < 2; ++k) \
        acc[ai][bj][m][n] = __builtin_amdgcn_mfma_f32_16x16x32_bf16(Bt[n][k], At[m][k], acc[ai][bj][m][n], 0, 0, 0); __builtin_amdgcn_s_setprio(0); } while (0)
#define PG8_WAIT_V(n) asm volatile("s_waitcnt vmcnt(" #n ")" ::: "memory")
#define PG8_WAIT_L(n) asm volatile("s_waitcnt lgkmcnt(" #n ")" ::: "memory")
#define PG8_BAR __builtin_amdgcn_s_barrier()
#define PG8_SCHED __builtin_amdgcn_sched_barrier(0)
    Unit cur, nxt; int ui = 0;
    if (!S.next(0, cur)) return;
    f32x4 acc[2][2][4][2];
#pragma unroll
    for (int a = 0; a < 2; ++a)
#pragma unroll
        for (int b = 0; b < 2; ++b)
#pragma unroll
            for (int m = 0; m < 4; ++m)
#pragma unroll
                for (int n = 0; n < 2; ++n) acc[a][b][m][n] = (f32x4){0.f, 0.f, 0.f, 0.f};
    bf16x8 At[4][2], B0[2][2], B1[2][2];
    const char* cA = (const char*)g.A + (size_t)cur.pm * tstep; const char* cB = (const char*)g.Bt + (size_t)cur.pn * tstep;
    PG8_STAGE(PG8_SB(0, 0), cB); PG8_STAGE(PG8_SA(0, 0), cA); PG8_STAGE(PG8_SB(0, 1), cB + hstep); PG8_STAGE(PG8_SA(0, 1), cA + hstep);
    if (wr == 1) PG8_BAR;
    PG8_WAIT_V(4); PG8_BAR;
    PG8_STAGE(PG8_SB(1, 0), cB + kstep); PG8_STAGE(PG8_SA(1, 0), cA + kstep); PG8_STAGE(PG8_SB(1, 1), cB + hstep + kstep);
    PG8_WAIT_V(6); PG8_BAR;
    for (;;) {
        const bool has_next = S.next(ui + 1, nxt);
        const char* nA = has_next ? (const char*)g.A + (size_t)nxt.pm * tstep : cA; const char* nB = has_next ? (const char*)g.Bt + (size_t)nxt.pn * tstep : cB;
        for (int t = 0; t < nt; t += 2) {
            const bool last = (t == nt - 2);
            const char* a1 = cA + (size_t)(t + 1) * kstep;
            const char* a2 = last ? nA : cA + (size_t)(t + 2) * kstep; const char* b2 = last ? nB : cB + (size_t)(t + 2) * kstep;
            const char* a3 = a2 + kstep; const char* b3 = b2 + kstep;
            if (Epi::RS_LDS && last) {
                const char* rsrc = (const char*)E.rss + (size_t)cur.pm * (BM * 64) + (size_t)wid * 2048 + (size_t)lane * 16;
                _Pragma("unroll") for (int _i = 0; _i < 2; ++_i)
                    __builtin_amdgcn_global_load_lds((const unsigned*)(rsrc + _i * 1024), (LAS unsigned*)(lds + STAGE_BYTES + wid * 2048 + _i * 1024), 16, 0, 0);
            }
            PG8_LDB(B0, 0, 0); PG8_SCHED; PG8_LDA(At, 0, 0); PG8_STAGE(PG8_SA(1, 1), a1 + hstep);
            PG8_WAIT_L(8); PG8_BAR; PG8_WAIT_L(0); PG8_MMA(0, 0, At, B0); PG8_BAR; PG8_SCHED;
            PG8_LDB(B1, 0, 1); PG8_STAGE(PG8_SB(0, 0), b2);
            PG8_BAR; PG8_WAIT_L(0); PG8_MMA(0, 1, At, B1); PG8_BAR;
            PG8_LDA(At, 0, 1); PG8_STAGE(PG8_SA(0, 0), a2);
            PG8_BAR; PG8_WAIT_L(0); PG8_MMA(1, 0, At, B0); PG8_BAR; PG8_SCHED;
            PG8_STAGE(PG8_SB(0, 1), b2 + hstep);
            PG8_WAIT_V(6); PG8_BAR; PG8_MMA(1, 1, At, B1); PG8_BAR;
            if (Epi::RS_LDS && last) rs_finalize(lds, wid);
            PG8_LDB(B0, 1, 0); PG8_SCHED; PG8_LDA(At, 1, 0); PG8_STAGE(PG8_SA(0, 1), a2 + hstep);
            PG8_WAIT_L(8); PG8_BAR; PG8_WAIT_L(0); PG8_MMA(0, 0, At, B0); PG8_BAR; PG8_SCHED;
            PG8_LDB(B1, 1, 1); PG8_STAGE(PG8_SB(1, 0), b3);
            PG8_BAR; PG8_WAIT_L(0); PG8_MMA(0, 1, At, B1); PG8_BAR;
            PG8_LDA(At, 1, 1); PG8_STAGE(PG8_SA(1, 0), a3);
            PG8_BAR; PG8_WAIT_L(0); PG8_MMA(1, 0, At, B0); PG8_BAR; PG8_SCHED;
            PG8_STAGE(PG8_SB(1, 1), b3 + hstep);
            PG8_WAIT_V(6); PG8_BAR; PG8_MMA(1, 1, At, B1); PG8_BAR;
        }
        { int l2; asm volatile("v_mbcnt_lo_u32_b32 %0, -1, 0\n\tv_mbcnt_hi_u32_b32 %0, -1, %0" : "=v"(l2));
          E(acc, cur, wr, wc, l2 & 15, l2 >> 4, lds); }
        if (!has_next) break;
#pragma unroll
        for (int a = 0; a < 2; ++a)
#pragma unroll
            for (int b = 0; b < 2; ++b)
#pragma unroll
                for (int m = 0; m < 4; ++m)
#pragma unroll
                    for (int n = 0; n < 2; ++n) acc[a][b][m][n] = (f32x4){0.f, 0.f, 0.f, 0.f};
        cur = nxt; cA = nA; cB = nB; ++ui;
    }
    PG8_WAIT_V(0);
    if (wr == 0) PG8_BAR;
    PG8_BAR;
#undef PG8_SA
#undef PG8_SB
#undef PG8_STAGE
#undef PG8_LDA
#undef PG8_LDB
#undef PG8_MMA
#undef PG8_WAIT_V
#undef PG8_WAIT_L
#undef PG8_BAR
#undef PG8_SCHED
}
}

enum { MODE_PLAIN = 0, MODE_SWIGLU = 1, MODE_AIN = 2 };
__device__ __forceinline__ void conv_item(const float* W, int Nsrc, int K, bf16_t* WT, const float* gain, float scale, int mode, int item, int npairs, LAS float* scr, int lane) {
    const int kb = item / npairs, P = item % npairs, G = 2 * P, k0 = 64 * kb;
    int cbase = 64 * P, nvalid = 64; float sc = scale;
    if (mode == MODE_SWIGLU) { const int pn = G >> 3, gi = G & 7, bj = gi >> 2, wc = gi & 3; cbase = (bj ? DFF : 0) + 128 * pn + 32 * wc; }
    else if (mode == MODE_AIN) {
        if (G < 16) sc = scale * 0.08838834764831845f;
        if (G >= 96) cbase = 3080 + 32 * (G - 96);
    }
    const int c4 = (lane & 15) * 4, r0 = lane >> 4;
    f32x4 v[16];
#pragma unroll
    for (int i = 0; i < 16; ++i) {
        const int kk = 4 * i + r0;
        v[i] = (f32x4){0.f, 0.f, 0.f, 0.f};
        if (c4 < nvalid) v[i] = *(const f32x4*)(W + (size_t)(k0 + kk) * Nsrc + cbase + c4);
    }
#pragma unroll
    for (int i = 0; i < 16; ++i) {
        const int kk = 4 * i + r0;
        const float gv = gain ? gain[k0 + kk] * sc : sc;
#pragma unroll
        for (int e = 0; e < 4; ++e) scr[kk * 65 + c4 + e] = v[i][e] * gv;
    }
    asm volatile("s_waitcnt lgkmcnt(0)" ::: "memory");
    const int c = lane & 7;
#pragma unroll
    for (int j = 0; j < 8; ++j) {
        const int nu = (lane >> 3) + 8 * j; const LAS float* sp = scr + (8 * c) * 65 + 32 * (nu >> 5) + perm32(nu & 31);
        u32x4 o; o.x = cvt_pk_bf16(sp[0 * 65], sp[1 * 65]); o.y = cvt_pk_bf16(sp[2 * 65], sp[3 * 65]); o.z = cvt_pk_bf16(sp[4 * 65], sp[5 * 65]); o.w = cvt_pk_bf16(sp[6 * 65], sp[7 * 65]);
        *(u32x4*)(WT + (size_t)(64 * P + nu) * K + k0 + 8 * c) = o;
    }
    asm volatile("s_waitcnt lgkmcnt(0)" ::: "memory");
}

__device__ __forceinline__ void convert_phase(const int tid, const Params& p, unsigned char* ws, int L, LAS unsigned char* lds, const int gw, const int NGW, const bool prologue) {
    const int lane = tid & 63, wave = tid >> 6;
    unsigned char* wsl = ws + ((L & 1) ? WS_SET1 : (size_t)0);
    LAS float* scr = (LAS float*)(lds + wave * 16640);
    const int j = L >> 1; const bool isA = (L & 1) == 0;
    const int I_WIN = 16 * 88, I_WOUT = 44 * 16, I_MIN = isA ? 16 * 56 : 16 * 28, I_MOUT = 24 * 16, I_MEM = prologue ? 16 * 16 : 0;
    const int total = 2 * I_WIN + 2 * I_WOUT + I_MIN + I_MOUT + I_MEM;
    for (int it = gw; it < total; it += NGW) {
        int r = it;
        if (r < I_WIN) { conv_item(INP(6) + (size_t)L * DM * 2 * DFF, 2 * DFF, DM, (bf16_t*)(wsl + WS_WIN0), INP(5) + L * DM, 1.f, MODE_SWIGLU, r, 88, scr, lane); continue; } r -= I_WIN;
        if (r < I_WIN) { conv_item(INP(10) + (size_t)L * DM * 2 * DFF, 2 * DFF, DM, (bf16_t*)(wsl + WS_WIN1), INP(9) + L * DM, 1.f, MODE_SWIGLU, r, 88, scr, lane); continue; } r -= I_WIN;
        if (r < I_WOUT) { conv_item(INP(7) + (size_t)L * DFF * DM, DM, DFF, (bf16_t*)(wsl + WS_WOUT0), nullptr, 0.5f, MODE_PLAIN, r, 16, scr, lane); continue; } r -= I_WOUT;
        if (r < I_WOUT) { conv_item(INP(11) + (size_t)L * DFF * DM, DM, DFF, (bf16_t*)(wsl + WS_WOUT1), nullptr, 0.5f, MODE_PLAIN, r, 16, scr, lane); continue; } r -= I_WOUT;
        if (r < I_MIN) {
            if (isA) conv_item(INP(14) + (size_t)j * DM * A_INW, A_INW, DM, (bf16_t*)(wsl + WS_MIN), INP(8) + L * DM, 1.f, MODE_AIN, r, 56, scr, lane);
            else conv_item(INP(18) + (size_t)j * DM * B_INW, B_INW, DM, (bf16_t*)(wsl + WS_MIN), INP(8) + L * DM, 1.f, MODE_PLAIN, r, 28, scr, lane);
            continue; } r -= I_MIN;
        if (r < I_MOUT) { conv_item((isA ? INP(17) : INP(22)) + (size_t)j * OUTK * DM, DM, OUTK, (bf16_t*)(wsl + WS_MOUT), nullptr, 1.f, MODE_PLAIN, r, 16, scr, lane); continue; } r -= I_MOUT;
        conv_item(INP(4), 1024, DM, (bf16_t*)(ws + WS_MEMW), INP(3), 1.f, MODE_PLAIN, r, 16, scr, lane);
    }
    if (isA) {
        const float* W = INP(14) + (size_t)j * DM * A_INW; const float* gain = INP(8) + L * DM; bf16_t* WG = (bf16_t*)(wsl + WS_WG);
        for (int idx = gw * 64 + lane; idx < 16 * DM; idx += NGW * 64) {
            const int r = idx >> 10, k2 = idx & 1023;
            const float v = (r < 8) ? W[(size_t)k2 * A_INW + 3072 + r] * gain[k2] : 0.f;
            WG[idx] = (bf16_t)(cvt_pk_bf16(v, 0.f) & 0xffffu);
        }
    }
    if (prologue) {
        bf16_t* xb = (bf16_t*)(ws + WS_XB); float* rss = (float*)(ws + WS_RSS);
        for (int rowb = gw; rowb < MTOK; rowb += 4 * NGW) {
            f32x4 v[4][4];
#pragma unroll
            for (int i = 0; i < 4; ++i) { const int row = rowb + i * NGW; const f32x4* xr = (const f32x4*)(INP(0) + (size_t)(row < MTOK ? row : 0) * DM) + lane;
#pragma unroll
                for (int q = 0; q < 4; ++q) v[i][q] = xr[64 * q]; }
#pragma unroll
            for (int i = 0; i < 4; ++i) {
                const int row = rowb + i * NGW;
                if (row < MTOK) {
                    float s = 0.f;
                    unsigned long long* o8 = (unsigned long long*)(xb + (size_t)row * DM) + lane;
                    unsigned* l4 = (unsigned*)(ws + WS_Y + (size_t)row * DM) + lane;
#pragma unroll
                    for (int q = 0; q < 4; ++q) { const f32x4 vv = v[i][q]; s += vv[0] * vv[0] + vv[1] * vv[1] + vv[2] * vv[2] + vv[3] * vv[3];
                        o8[64 * q] = (unsigned long long)cvt_pk_bf16(vv[0], vv[1]) | ((unsigned long long)cvt_pk_bf16(vv[2], vv[3]) << 32); }
                    s = wave_sum(s);
                    if (lane < 16) rss[(size_t)row * 16 + lane] = (lane == 0) ? s : 0.f;
                }
            }
        }
        bf16_t* mb = (bf16_t*)(ws + WS_MEMB); float* mrs = (float*)(ws + WS_MEMRS);
        for (int row = gw; row < MROWS; row += NGW) {
            const f32x4* xr = (const f32x4*)(INP(1) + (size_t)row * DM) + lane; float s = 0.f;
            unsigned long long* o8 = (unsigned long long*)(mb + (size_t)row * DM) + lane;
#pragma unroll
            for (int q = 0; q < 4; ++q) { const f32x4 v = xr[64 * q]; s += v[0] * v[0] + v[1] * v[1] + v[2] * v[2] + v[3] * v[3];
                o8[64 * q] = (unsigned long long)cvt_pk_bf16(v[0], v[1]) | ((unsigned long long)cvt_pk_bf16(v[2], v[3]) << 32); }
            s = wave_sum(s);
            if (lane == 0) mrs[row] = 1.0f / sqrtf(s * (1.0f / 1024.0f) + EPS);
        }
        float* rope = (float*)(ws + WS_ROPE); const int* pos = (const int*)INP(2);
        for (int e = blockIdx.x * NTHREADS + tid; e < MTOK * 8; e += gridDim.x * NTHREADS) {
            const int tok = e >> 3, i = e & 7;
            const float ang = (float)pos[tok] * __builtin_amdgcn_exp2f((float)i * (-18.931568569324174f / 8.0f));
            const float kq = rintf(ang * 0.636619772367581343f);
            float t = fmaf(-kq, 1.5703125f, ang); t = fmaf(-kq, 4.837512969970703125e-4f, t); t = fmaf(-kq, 7.54978995489188e-8f, t);
            const float t2 = t * t;
            const float sn = t * (1.0f + t2 * (-1.0f / 6 + t2 * (1.0f / 120 + t2 * (-1.0f / 5040 + t2 * (1.0f / 362880)))));
            const float cs = 1.0f + t2 * (-0.5f + t2 * (1.0f / 24 + t2 * (-1.0f / 720 + t2 * (1.0f / 40320 + t2 * (-1.0f / 3628800)))));
            const int q = ((int)kq) & 3;
            float c_, s_;
            if (q == 0) { c_ = cs; s_ = sn; } else if (q == 1) { c_ = -sn; s_ = cs; } else if (q == 2) { c_ = -cs; s_ = -sn; } else { c_ = sn; s_ = -cs; }
            rope[(size_t)tok * 16 + i] = c_; rope[(size_t)tok * 16 + 8 + i] = s_;
        }
    }
}

constexpr int LDK_M = 136, LDV_M = 264;
__device__ __forceinline__ void mem_attn_item(const int tid, const Params& p, unsigned char* ws, int L, int item, const bf16_t* proj, int ldp, int xq_off, bf16_t* Y, LAS unsigned char* lds) {
    const int lane = tid & 63, wave = tid >> 6, g = lane >> 4, c = lane & 15;
    const int b = item >> 5, h = (item >> 3) & 3, tile = item & 7;
    LAS bf16_t* Kh = (LAS bf16_t*)lds;
    LAS bf16_t* VT = (LAS bf16_t*)(lds + 256 * LDK_M * 2);
    LAS float* GG = (LAS float*)(lds + 256 * LDK_M * 2 + 128 * LDV_M * 2);
    const bf16_t* MK = (const bf16_t*)(ws + WS_MEMK); const bf16_t* MVT = (const bf16_t*)(ws + WS_MEMVT);
    __syncthreads();
    if (tid < 128) GG[tid] = INP(12)[L * 128 + tid] * INP(13)[L * 128 + tid] * 0.08838834764831845f;
    {
        const int ch = tid & 15;
#pragma unroll
        for (int it = 0; it < 8; ++it) {
            const int m = (tid >> 4) + 32 * it;
            const u32x4 w = *(const u32x4*)(MK + (size_t)(b * 256 + m) * 512 + h * 128 + ch * 8);
            float v[8] = {bflo(w.x), bfhi(w.x), bflo(w.y), bfhi(w.y), bflo(w.z), bfhi(w.z), bflo(w.w), bfhi(w.w)};
            float s = 0.f;
#pragma unroll
            for (int e = 0; e < 8; ++e) s += v[e] * v[e];
            s = rowsum16(s);
            const float rs = 1.0f / sqrtf(s * (1.0f / 128.0f) + EPS);
            u32x4 o; o.x = cvt_pk_bf16(v[0] * rs, v[1] * rs); o.y = cvt_pk_bf16(v[2] * rs, v[3] * rs); o.z = cvt_pk_bf16(v[4] * rs, v[5] * rs); o.w = cvt_pk_bf16(v[6] * rs, v[7] * rs);
            *(LAS u32x4*)(Kh + m * LDK_M + ch * 8) = o;
        }
        const int ch2 = tid & 31;
#pragma unroll
        for (int it = 0; it < 8; ++it) {
            const int dv = (tid >> 5) + 16 * it;
            const u32x4 w = *(const u32x4*)(MVT + ((size_t)(b * 4 + h) * 128 + dv) * 256 + ch2 * 8);
            *(LAS u32x4*)(VT + dv * LDV_M + ch2 * 8) = w;
        }
    }
    __syncthreads();
#pragma unroll 1
    for (int qt = 0; qt < 2; ++qt) {
        const int tok = tile * 256 + wave * 32 + qt * 16 + c;
        const size_t row = (size_t)b * SEQ + tok;
        bf16x8 qf[4];
        {
            float v[4][8]; float s = 0.f;
#pragma unroll
            for (int ds = 0; ds < 4; ++ds) {
                const u32x4 w = *(const u32x4*)(proj + row * ldp + xq_off + h * 128 + 32 * ds + 8 * g);
                v[ds][0] = bflo(w.x); v[ds][1] = bfhi(w.x); v[ds][2] = bflo(w.y); v[ds][3] = bfhi(w.y); v[ds][4] = bflo(w.z); v[ds][5] = bfhi(w.z); v[ds][6] = bflo(w.w); v[ds][7] = bfhi(w.w);
#pragma unroll
                for (int e = 0; e < 8; ++e) s += v[ds][e] * v[ds][e];
            }
            s = xsum16(s); s = xsum32(s);
            const float rs = 1.0f / sqrtf(s * (1.0f / 128.0f) + EPS);
#pragma unroll
            for (int ds = 0; ds < 4; ++ds) {
                float t[8];
#pragma unroll
                for (int e = 0; e < 8; ++e) t[e] = v[ds][e] * rs * GG[32 * ds + 8 * g + e];
                u32x4 o; o.x = cvt_pk_bf16(t[0], t[1]); o.y = cvt_pk_bf16(t[2], t[3]); o.z = cvt_pk_bf16(t[4], t[5]); o.w = cvt_pk_bf16(t[6], t[7]);
                qf[ds] = __builtin_bit_cast(bf16x8, o);
            }
        }
        f32x4 st[16];
#pragma unroll
        for (int kt = 0; kt < 16; ++kt) {
            f32x4 a = {0.f, 0.f, 0.f, 0.f};
#pragma unroll
            for (int ds = 0; ds < 4; ++ds) a = mfma16(lds8(Kh, LDK_M, 16 * kt + c, 32 * ds + 8 * g), qf[ds], a);
            st[kt] = a;
            if ((kt & 3) == 3) __builtin_amdgcn_sched_barrier(0);
        }
        float mx = -3.0e38f;
#pragma unroll
        for (int kt = 0; kt < 16; ++kt)
#pragma unroll
            for (int r = 0; r < 4; ++r) mx = fmaxf(mx, st[kt][r]);
        mx = xmax16(mx); mx = xmax32(mx);
        float sum = 0.f;
#pragma unroll
        for (int kt = 0; kt < 16; ++kt)
#pragma unroll
            for (int r = 0; r < 4; ++r) { const float e = fast_exp(st[kt][r] - mx); st[kt][r] = e; sum += e; }
        sum = xsum16(sum); sum = xsum32(sum);
        const float inv = 1.0f / sum;
        f32x4 o[8];
#pragma unroll
        for (int dt = 0; dt < 8; ++dt) o[dt] = (f32x4){0.f, 0.f, 0.f, 0.f};
#pragma unroll
        for (int u = 0; u < 8; ++u) {
            const bf16x8 pb = pack8(st[2 * u], st[2 * u + 1]);
#pragma unroll
            for (int dt = 0; dt < 8; ++dt) o[dt] = mfma16(lds4x2(VT, LDV_M, 16 * dt + c, 32 * u + 4 * g), pb, o[dt]);
        }
#pragma unroll
        for (int dt = 0; dt < 8; ++dt) {
            u32x2 w; w.x = cvt_pk_bf16(o[dt][0] * inv, o[dt][1] * inv); w.y = cvt_pk_bf16(o[dt][2] * inv, o[dt][3] * inv);
            *(u32x2*)(Y + row * OUTK + 1024 + h * 128 + 16 * dt + 4 * g) = w;
        }
    }
}

constexpr int LDK_S = 72, LDV_S = 264;
__device__ __forceinline__ void swa_item(const int tid, const Params& p, unsigned char* ws, int jb, int item, const bf16_t* proj, bf16_t* Y, LAS unsigned char* lds) {
    const int lane = tid & 63, wave = tid >> 6, g = lane >> 4, c = lane & 15;
    const int b = item >> 5, n = (item >> 1) & 15, kvh = item & 1;
    LAS bf16_t* Kn = (LAS bf16_t*)lds;
    LAS bf16_t* VT = (LAS bf16_t*)(lds + 256 * LDK_S * 2);
    LAS float* GQ = (LAS float*)(lds + 256 * LDK_S * 2 + 64 * LDV_S * 2);
    const float* rope = (const float*)(ws + WS_ROPE);
    __syncthreads();
    if (tid < 64) { GQ[tid] = INP(19)[jb * 64 + tid]; GQ[64 + tid] = INP(20)[jb * 64 + tid]; }
    __syncthreads();
    {
        const int ch = tid & 7;
#pragma unroll
        for (int it = 0; it < 4; ++it) {
            const int kj = (tid >> 3) + 64 * it;
            const int tok = (n - 1) * 128 + kj;
            u32x4 ko = {0u, 0u, 0u, 0u}; float vv[8] = {0.f, 0.f, 0.f, 0.f, 0.f, 0.f, 0.f, 0.f};
            const bool ok = tok >= 0;
            const size_t row = (size_t)b * SEQ + (ok ? tok : 0);
            const u32x4 kw = *(const u32x4*)(proj + row * B_INW + 1024 + kvh * 64 + ch * 8);
            const u32x4 vw = *(const u32x4*)(proj + row * B_INW + 1152 + kvh * 64 + ch * 8);
            float kv[8] = {bflo(kw.x), bfhi(kw.x), bflo(kw.y), bfhi(kw.y), bflo(kw.z), bfhi(kw.z), bflo(kw.w), bfhi(kw.w)};
            float s = 0.f;
#pragma unroll
            for (int e = 0; e < 8; ++e) s += kv[e] * kv[e];
            s = rowsum8(s);
            const float rs = 1.0f / sqrtf(s * (1.0f / 64.0f) + EPS);
#pragma unroll
            for (int e = 0; e < 8; ++e) kv[e] = kv[e] * rs * GQ[64 + ch * 8 + e];
            float other[8];
#pragma unroll
            for (int e = 0; e < 8; ++e) other[e] = dpp_x1(kv[e]);
            if (ch < 2) {
                const f32x4 c0 = *(const f32x4*)(rope + row * 16), c1 = *(const f32x4*)(rope + row * 16 + 4), s0 = *(const f32x4*)(rope + row * 16 + 8), s1 = *(const f32x4*)(rope + row * 16 + 12);
                const float cs[8] = {c0[0], c0[1], c0[2], c0[3], c1[0], c1[1], c1[2], c1[3]}, sn[8] = {s0[0], s0[1], s0[2], s0[3], s1[0], s1[1], s1[2], s1[3]};
#pragma unroll
                for (int e = 0; e < 8; ++e) kv[e] = (ch == 0) ? (kv[e] * cs[e] - other[e] * sn[e]) : (kv[e] * cs[e] + other[e] * sn[e]);
            }
            if (ok) {
                ko.x = cvt_pk_bf16(kv[0], kv[1]); ko.y = cvt_pk_bf16(kv[2], kv[3]); ko.z = cvt_pk_bf16(kv[4], kv[5]); ko.w = cvt_pk_bf16(kv[6], kv[7]);
            }
            *(LAS u32x4*)(Kn + kj * LDK_S + ch * 8) = ko;
            const unsigned vws[4] = {ok ? vw.x : 0u, ok ? vw.y : 0u, ok ? vw.z : 0u, ok ? vw.w : 0u};
#pragma unroll
            for (int e = 0; e < 4; ++e) { VT[(ch * 8 + 2 * e) * LDV_S + kj] = (bf16_t)(vws[e] & 0xffffu); VT[(ch * 8 + 2 * e + 1) * LDV_S + kj] = (bf16_t)(vws[e] >> 16); }
            (void)vv;
        }
    }
    __syncthreads();
    const int head = kvh * 8 + wave;
    const float sink = INP(21)[jb * 16 + head];
#pragma unroll 1
    for (int i = 0; i < 4; ++i) {
        bf16x8 qf[2][2];
#pragma unroll
        for (int qt = 0; qt < 2; ++qt) {
            const int tok = n * 128 + 32 * i + 16 * qt + c;
            const size_t row = (size_t)b * SEQ + tok;
            float v[2][8]; float s = 0.f;
#pragma unroll
            for (int ds = 0; ds < 2; ++ds) {
                const u32x4 w = *(const u32x4*)(proj + row * B_INW + head * 64 + 32 * ds + 8 * g);
                v[ds][0] = bflo(w.x); v[ds][1] = bfhi(w.x); v[ds][2] = bflo(w.y); v[ds][3] = bfhi(w.y); v[ds][4] = bflo(w.z); v[ds][5] = bfhi(w.z); v[ds][6] = bflo(w.w); v[ds][7] = bfhi(w.w);
#pragma unroll
                for (int e = 0; e < 8; ++e) s += v[ds][e] * v[ds][e];
            }
            s = xsum16(s); s = xsum32(s);
            const float rs = 1.0f / sqrtf(s * (1.0f / 64.0f) + EPS);
#pragma unroll
            for (int ds = 0; ds < 2; ++ds)
#pragma unroll
                for (int e = 0; e < 8; ++e) v[ds][e] = v[ds][e] * rs * GQ[32 * ds + 8 * g + e];
            {
                float other[8];
#pragma unroll
                for (int e = 0; e < 8; ++e) other[e] = shfl_from(v[0][e], lane ^ 16);
                if (g < 2) {
                    const f32x4 c0 = *(const f32x4*)(rope + row * 16), c1 = *(const f32x4*)(rope + row * 16 + 4), s0 = *(const f32x4*)(rope + row * 16 + 8), s1 = *(const f32x4*)(rope + row * 16 + 12);
                    const float cs[8] = {c0[0], c0[1], c0[2], c0[3], c1[0], c1[1], c1[2], c1[3]}, sn[8] = {s0[0], s0[1], s0[2], s0[3], s1[0], s1[1], s1[2], s1[3]};
#pragma unroll
                    for (int e = 0; e < 8; ++e) v[0][e] = (g == 0) ? (v[0][e] * cs[e] - other[e] * sn[e]) : (v[0][e] * cs[e] + other[e] * sn[e]);
                }
            }
#pragma unroll
            for (int ds = 0; ds < 2; ++ds) {
                u32x4 o; o.x = cvt_pk_bf16(v[ds][0] * 0.125f, v[ds][1] * 0.125f); o.y = cvt_pk_bf16(v[ds][2] * 0.125f, v[ds][3] * 0.125f);
                o.z = cvt_pk_bf16(v[ds][4] * 0.125f, v[ds][5] * 0.125f); o.w = cvt_pk_bf16(v[ds][6] * 0.125f, v[ds][7] * 0.125f);
                qf[qt][ds] = __builtin_bit_cast(bf16x8, o);
            }
        }
        f32x4 st[10][2];
#pragma unroll
        for (int kt = 0; kt < 10; ++kt) {
            const bf16x8 k0 = lds8(Kn, LDK_S, 32 * i + 16 * kt + c, 8 * g), k1 = lds8(Kn, LDK_S, 32 * i + 16 * kt + c, 32 + 8 * g);
#pragma unroll
            for (int qt = 0; qt < 2; ++qt) { f32x4 a = {0.f, 0.f, 0.f, 0.f}; a = mfma16(k0, qf[qt][0], a); a = mfma16(k1, qf[qt][1], a); st[kt][qt] = a; }
        }
        float inv[2];
#pragma unroll
        for (int qt = 0; qt < 2; ++qt) {
            float mx = sink;
#pragma unroll
            for (int kt = 0; kt < 10; ++kt)
#pragma unroll
                for (int r = 0; r < 4; ++r) {
                    const int kj = 32 * i + 16 * kt + 4 * g + r, diff = 128 + 32 * i + 16 * qt + c - kj;
                    const bool valid = (diff >= 0) && (diff < 128) && (n > 0 || kj >= 128);
                    const float sv = valid ? st[kt][qt][r] : -3.0e38f; st[kt][qt][r] = sv; mx = fmaxf(mx, sv);
                }
            mx = xmax16(mx); mx = xmax32(mx);
            float sum = 0.f;
#pragma unroll
            for (int kt = 0; kt < 10; ++kt)
#pragma unroll
                for (int r = 0; r < 4; ++r) { const float sv = st[kt][qt][r]; const float e = (sv > -1.0e38f) ? fast_exp(sv - mx) : 0.f; st[kt][qt][r] = e; sum += e; }
            sum = xsum16(sum); sum = xsum32(sum);
            inv[qt] = 1.0f / (sum + fast_exp(sink - mx));
        }
        f32x4 o[4][2];
#pragma unroll
        for (int dt = 0; dt < 4; ++dt)
#pragma unroll
            for (int qt = 0; qt < 2; ++qt) o[dt][qt] = (f32x4){0.f, 0.f, 0.f, 0.f};
#pragma unroll
        for (int u = 0; u < 5; ++u) {
            const bf16x8 pb0 = pack8(st[2 * u][0], st[2 * u + 1][0]), pb1 = pack8(st[2 * u][1], st[2 * u + 1][1]);
#pragma unroll
            for (int dt = 0; dt < 4; ++dt) {
                const bf16x8 vf = lds4x2(VT, LDV_S, 16 * dt + c, 32 * i + 32 * u + 4 * g);
                o[dt][0] = mfma16(vf, pb0, o[dt][0]); o[dt][1] = mfma16(vf, pb1, o[dt][1]);
            }
        }
#pragma unroll
        for (int qt = 0; qt < 2; ++qt) {
            const int tok = n * 128 + 32 * i + 16 * qt + c;
            const size_t row = (size_t)b * SEQ + tok;
#pragma unroll
            for (int dt = 0; dt < 4; ++dt) {
                u32x2 w; w.x = cvt_pk_bf16(o[dt][qt][0] * inv[qt], o[dt][qt][1] * inv[qt]); w.y = cvt_pk_bf16(o[dt][qt][2] * inv[qt], o[dt][qt][3] * inv[qt]);
                *(u32x2*)(Y + row * OUTK + head * 64 + 16 * dt + 4 * g) = w;
            }
        }
    }
}

typedef short s16x4 __attribute__((ext_vector_type(4)));
__device__ __forceinline__ bf16x8 ldstr8(const LAS bf16_t* base, int ld, int s0, int col0, int i, int hi_row_off) {
    const LAS bf16_t* a = base + (s0 + (i >> 2)) * ld + col0 + 4 * (i & 3);
    const s16x4 lo = __builtin_amdgcn_ds_read_tr16_b64_v4i16((LAS s16x4*)a);
    const s16x4 hi = __builtin_amdgcn_ds_read_tr16_b64_v4i16((LAS s16x4*)(a + hi_row_off * ld));
    return (bf16x8){lo.x, lo.y, lo.z, lo.w, hi.x, hi.y, hi.z, hi.w};
}
constexpr int LDQ_A = 136, LDT_A = 72, LDV_A = 264;
constexpr int ML_QS = 0, ML_KS = ML_QS + 64 * LDQ_A * 2, ML_KW = ML_KS + 64 * LDQ_A * 2, ML_VS = ML_KW + 64 * LDQ_A * 2, ML_SS = ML_VS + 64 * LDV_A * 2,
              ML_A = ML_SS + 64 * LDT_A * 2, ML_PM = ML_A + 2048 * 4, ML_MM = ML_PM + 2048 * 4, ML_MST = ML_MM + 2048 * 4, ML_NV = ML_MST + 64 * 4, ML_QN = ML_NV + 128 * 4,
              ML_DENP = ML_QN + 64 * 4, ML_HSQ = ML_DENP + 128 * 4, ML_NVP = ML_HSQ + 512 * 4, ML_END = ML_NVP + 512 * 4;
static_assert(ML_END <= LDS_BYTES - 16, "mLSTM LDS");
constexpr int ML_GROUPS = 4, ML_CPG = 32 / ML_GROUPS, ML_SLOT = 256 * 128 + 128;
constexpr size_t WS_MLST = WS_Y + (size_t)34 * 1024 * 1024;
template <int MODE>
__device__ __forceinline__ void mlstm_item(const int tid_in, const Params& p, unsigned char* ws, int ja, int item, int grp, const bf16_t* proj, bf16_t* Y, LAS unsigned char* lds) {
    int tid = tid_in;
    int lane = tid & 63, wave = __builtin_amdgcn_readfirstlane(tid >> 6), g = lane >> 4, c = lane & 15;
    const int b = item >> 2, h = item & 3;
    LAS bf16_t* Qs = (LAS bf16_t*)(lds + ML_QS); LAS bf16_t* Ks = (LAS bf16_t*)(lds + ML_KS); LAS bf16_t* Kw = (LAS bf16_t*)(lds + ML_KW);
    LAS bf16_t* Vs = (LAS bf16_t*)(lds + ML_VS); LAS bf16_t* Ss = (LAS bf16_t*)(lds + ML_SS);
    LAS float* A_ = (LAS float*)(lds + ML_A); LAS float* PM_ = (LAS float*)(lds + ML_PM); LAS float* MM_ = (LAS float*)(lds + ML_MM); LAS float* MST_ = (LAS float*)(lds + ML_MST);
    LAS float* NV = (LAS float*)(lds + ML_NV); LAS float* QN = (LAS float*)(lds + ML_QN); LAS float* DENP = (LAS float*)(lds + ML_DENP); LAS float* HSQ = (LAS float*)(lds + ML_HSQ); LAS float* NVP = (LAS float*)(lds + ML_NVP);
    const float* gates = (const float*)(ws + WS_GATES);
    const float* hg = INP(16) + ja * 1024 + h * 256;
    float* SB = (float*)(ws + WS_MLST);
    const GAS char* projb = (const GAS char*)proj; GAS char* Yb8 = (GAS char*)Y;
    const int ck0 = grp * ML_CPG, ck1 = ck0 + ML_CPG;
    __syncthreads();
#pragma unroll 1
    for (int cc = 0; cc < 4; ++cc) {
        const int t = 64 * (4 * wave + cc) + lane; const size_t row = (size_t)b * SEQ + t;
        const float ip = gates[row * 8 + h], lf = gates[row * 8 + 4 + h];
        float bs = lf;
#pragma unroll
        for (int o = 1; o < 64; o <<= 1) { const float v2 = shfl_from(bs, lane >= o ? lane - o : lane); if (lane >= o) bs += v2; }
        const float a = ip - bs; float pm = a;
#pragma unroll
        for (int o = 1; o < 64; o <<= 1) { const float v2 = shfl_from(pm, lane >= o ? lane - o : lane); if (lane >= o) pm = fmaxf(pm, v2); }
        A_[t] = a; PM_[t] = pm; MM_[t] = bs;
    }
    if (tid < 128) NV[tid] = 0.f;
    __syncthreads();
    if (tid == 0) { float m = 0.f; for (int ck = 0; ck < 32; ++ck) { MST_[ck] = m; m = MM_[64 * ck + 63] + fmaxf(m, PM_[64 * ck + 63]); } }
    __syncthreads();
#pragma unroll
    for (int q = 0; q < 4; ++q) { const int t = tid + 512 * q; const float pm = fmaxf(MST_[t >> 6], PM_[t]); PM_[t] = pm; MM_[t] = MM_[t] + pm; }
    f32x4 st[8][2];
#pragma unroll
    for (int mt = 0; mt < 8; ++mt)
#pragma unroll
        for (int vt = 0; vt < 2; ++vt) st[mt][vt] = (f32x4){0.f, 0.f, 0.f, 0.f};
    if (MODE == 2 && grp > 0) {
        __syncthreads();
#pragma unroll 1
        for (int gp = 0; gp < grp; ++gp) {
            float ex = 0.f;
            for (int k2 = (gp + 1) * ML_CPG; k2 < ck0; ++k2) ex += MST_[k2] - PM_[64 * k2 + 63];
            const float wgt = fast_exp(ex);
            const float* sl = SB + (size_t)((b * 4 + h) * 3 + gp) * ML_SLOT;
#pragma unroll
            for (int mt = 0; mt < 8; ++mt)
#pragma unroll
                for (int vt = 0; vt < 2; ++vt) st[mt][vt] += wgt * *(const f32x4*)(sl + (32 * wave + 16 * vt + c) * 128 + 16 * mt + 4 * g);
            if (tid < 128) NV[tid] += wgt * sl[256 * 128 + tid];
        }
    }
    u32x4 qreg[2], kreg[2], vreg[4];
    {
        const unsigned row0 = (unsigned)(b * SEQ + 64 * ck0);
#pragma unroll
        for (int it = 0; it < 2; ++it) { const int idx = tid + 512 * it, s_ = idx >> 4, ch = idx & 15;
            if (MODE == 2) qreg[it] = *(const GAS u32x4*)(projb + ((row0 + s_) * A_LDP + h * 128 + ch * 8) * 2u);
            kreg[it] = *(const GAS u32x4*)(projb + ((row0 + s_) * A_LDP + 512 + h * 128 + ch * 8) * 2u); }
#pragma unroll
        for (int it = 0; it < 4; ++it) { const int idx = tid + 512 * it, s_ = idx >> 5, ch = idx & 31; vreg[it] = *(const GAS u32x4*)(projb + ((row0 + s_) * A_LDP + 1024 + h * 256 + ch * 8) * 2u); }
    }
#pragma unroll 1
    for (int ck = ck0; ck < ck1; ++ck) {
        const int t0 = 64 * ck; const unsigned row0 = (unsigned)(b * SEQ + t0);
        asm volatile("" : "+v"(tid)); lane = tid & 63; g = lane >> 4; c = lane & 15;
        __syncthreads();
        const float m_st = MST_[ck], pm_last = PM_[t0 + 63];
        if (ck > ck0 && tid < 128) {
            const float dprev = fast_exp(MST_[ck - 1] - PM_[t0 - 1]);
            NV[tid] = dprev * NV[tid] + ((NVP[tid] + NVP[128 + tid]) + (NVP[256 + tid] + NVP[384 + tid]));
        }
        {
#pragma unroll
            for (int it = 0; it < 2; ++it) {
                const int idx = tid + 512 * it, s_ = idx >> 4, ch = idx & 15;
                const u32x4 kw = kreg[it];
                if (MODE == 2) { *(LAS u32x4*)(Qs + s_ * LDQ_A + ch * 8) = qreg[it]; *(LAS u32x4*)(Ks + s_ * LDQ_A + ch * 8) = kw; }
                const float w = fast_exp(A_[t0 + s_] - pm_last);
                u32x4 o; o.x = cvt_pk_bf16(bflo(kw.x) * w, bfhi(kw.x) * w); o.y = cvt_pk_bf16(bflo(kw.y) * w, bfhi(kw.y) * w); o.z = cvt_pk_bf16(bflo(kw.z) * w, bfhi(kw.z) * w); o.w = cvt_pk_bf16(bflo(kw.w) * w, bfhi(kw.w) * w);
                *(LAS u32x4*)(Kw + s_ * LDQ_A + ch * 8) = o;
            }
#pragma unroll
            for (int it = 0; it < 4; ++it) { const int idx = tid + 512 * it, s_ = idx >> 5, ch = idx & 31; *(LAS u32x4*)(Vs + s_ * LDV_A + ch * 8) = vreg[it]; }
        }
        u32x2 ogr[4][2];
        if (MODE == 2) {
#pragma unroll
            for (int jt = 0; jt < 4; ++jt)
#pragma unroll
                for (int vt = 0; vt < 2; ++vt) ogr[jt][vt] = *(const GAS u32x2*)(projb + ((row0 + 16 * jt + c) * A_LDP + 2048 + h * 256 + 32 * wave + 16 * vt + 4 * g) * 2u);
        }
        if (ck + 1 < ck1) {
            const unsigned rown = row0 + 64u;
#pragma unroll
            for (int it = 0; it < 2; ++it) { const int idx = tid + 512 * it, s_ = idx >> 4, ch = idx & 15;
                if (MODE == 2) qreg[it] = *(const GAS u32x4*)(projb + ((rown + s_) * A_LDP + h * 128 + ch * 8) * 2u);
                kreg[it] = *(const GAS u32x4*)(projb + ((rown + s_) * A_LDP + 512 + h * 128 + ch * 8) * 2u); }
#pragma unroll
            for (int it = 0; it < 4; ++it) { const int idx = tid + 512 * it, s_ = idx >> 5, ch = idx & 31; vreg[it] = *(const GAS u32x4*)(projb + ((rown + s_) * A_LDP + 1024 + h * 256 + ch * 8) * 2u); }
        }
        __syncthreads();
        if constexpr (MODE == 2) {
        {
            const int j = tid >> 3, part = tid & 7; float s = 0.f;
#pragma unroll
            for (int hh = 0; hh < 2; ++hh) {
                const u32x4 qw = *(const LAS u32x4*)(Qs + j * LDQ_A + 16 * part + 8 * hh);
                const f32x4 n0 = *(const LAS f32x4*)(NV + 16 * part + 8 * hh), n1 = *(const LAS f32x4*)(NV + 16 * part + 8 * hh + 4);
                s += bflo(qw.x) * n0[0] + bfhi(qw.x) * n0[1] + bflo(qw.y) * n0[2] + bfhi(qw.y) * n0[3] + bflo(qw.z) * n1[0] + bfhi(qw.z) * n1[1] + bflo(qw.w) * n1[2] + bfhi(qw.w) * n1[3];
            }
            s = rowsum8(s);
            if (part == 0) QN[j] = s;
        }
        {
            const int jt = wave >> 1, sp = wave & 1;
            float dsum[4] = {0.f, 0.f, 0.f, 0.f};
#pragma unroll
            for (int q = 0; q < 2; ++q) {
                const int stl = 2 * sp + q;
                f32x4 a = {0.f, 0.f, 0.f, 0.f};
                if (stl <= jt) {
#pragma unroll
                    for (int ds = 0; ds < 4; ++ds) a = mfma16(lds8(Qs, LDQ_A, 16 * jt + c, 32 * ds + 8 * g), lds8(Ks, LDQ_A, 16 * stl + c, 32 * ds + 8 * g), a);
                }
                const int s = 16 * stl + c; const float as = A_[t0 + s];
#pragma unroll
                for (int r = 0; r < 4; ++r) {
                    const int j = 16 * jt + 4 * g + r;
                    float v = 0.f;
                    if (s <= j) v = a[r] * fast_exp(as - PM_[t0 + j]);
                    const unsigned short hb = (unsigned short)(cvt_pk_bf16(v, 0.f) & 0xffffu);
                    Ss[j * LDT_A + s] = hb; dsum[r] += bf2f(hb);
                }
            }
#pragma unroll
            for (int r = 0; r < 4; ++r) { float v = rowsum16(dsum[r]); if (c == 0) DENP[(16 * jt + 4 * g + r) * 2 + sp] = v; }
        }
        __syncthreads();
        f32x4 hv[4][2];
#pragma unroll
        for (int jt = 0; jt < 4; ++jt)
#pragma unroll
            for (int vt = 0; vt < 2; ++vt) hv[jt][vt] = (f32x4){0.f, 0.f, 0.f, 0.f};
#pragma unroll
        for (int ks = 0; ks < 2; ++ks) {
            const bf16x8 va0 = ldstr8(Vs, LDV_A, 32 * ks + 8 * g, 32 * wave, c, 4), va1 = ldstr8(Vs, LDV_A, 32 * ks + 8 * g, 32 * wave + 16, c, 4);
#pragma unroll
            for (int jt = 0; jt < 4; ++jt) {
                if (ks == 1 && jt < 2) continue;
                const bf16x8 sb = lds8(Ss, LDT_A, 16 * jt + c, 32 * ks + 8 * g);
                hv[jt][0] = mfma16(va0, sb, hv[jt][0]); hv[jt][1] = mfma16(va1, sb, hv[jt][1]);
            }
        }
#pragma unroll
        for (int hf = 0; hf < 2; ++hf) {
            f32x4 hq[2][2];
#pragma unroll
            for (int q = 0; q < 2; ++q)
#pragma unroll
                for (int vt = 0; vt < 2; ++vt) hq[q][vt] = (f32x4){0.f, 0.f, 0.f, 0.f};
#pragma unroll
            for (int u = 0; u < 4; ++u) {
                const bf16x8 ca0 = pack8(st[2 * u][0], st[2 * u + 1][0]), ca1 = pack8(st[2 * u][1], st[2 * u + 1][1]);
#pragma unroll
                for (int q = 0; q < 2; ++q) {
                    const bf16x8 qb = lds4x2(Qs, LDQ_A, 16 * (2 * hf + q) + c, 32 * u + 4 * g);
                    hq[q][0] = mfma16(ca0, qb, hq[q][0]); hq[q][1] = mfma16(ca1, qb, hq[q][1]);
                }
            }
#pragma unroll
            for (int q = 0; q < 2; ++q) {
                const int jt = 2 * hf + q, j = 16 * jt + c;
                const float inter = fast_exp(m_st - PM_[t0 + j]);
                const float den = DENP[2 * j] + DENP[2 * j + 1] + inter * QN[j];
                const float dd = fmaxf(fabsf(den), fast_exp(-MM_[t0 + j]));
                const float rd = 1.0f / dd;
                float sq = 0.f;
#pragma unroll
                for (int vt = 0; vt < 2; ++vt)
#pragma unroll
                    for (int r = 0; r < 4; ++r) { const float hh = (hv[jt][vt][r] + inter * hq[q][vt][r]) * rd; hv[jt][vt][r] = hh; sq += hh * hh; }
                sq = xsum16(sq); sq = xsum32(sq);
                if (g == 0) HSQ[j * 8 + wave] = sq;
            }
        }
        __syncthreads();
        {
            const f32x4 hg0 = *(const f32x4*)(hg + 32 * wave + 4 * g), hg1 = *(const f32x4*)(hg + 32 * wave + 16 + 4 * g);
#pragma unroll
            for (int jt = 0; jt < 4; ++jt) {
                const int j = 16 * jt + c;
                const f32x4 q0 = *(const LAS f32x4*)(HSQ + j * 8), q1 = *(const LAS f32x4*)(HSQ + j * 8 + 4);
                const float sq = (q0[0] + q0[1]) + (q0[2] + q0[3]) + (q1[0] + q1[1]) + (q1[2] + q1[3]);
                const float rs = 1.0f / sqrtf(sq * (1.0f / 256.0f) + EPS);
#pragma unroll
                for (int vt = 0; vt < 2; ++vt) {
                    const f32x4 gg = vt ? hg1 : hg0; const u32x2 ow = ogr[jt][vt];
                    const float y0 = hv[jt][vt][0] * rs * gg[0] * sigmoidf_(bflo(ow.x)), y1 = hv[jt][vt][1] * rs * gg[1] * sigmoidf_(bfhi(ow.x));
                    const float y2 = hv[jt][vt][2] * rs * gg[2] * sigmoidf_(bflo(ow.y)), y3 = hv[jt][vt][3] * rs * gg[3] * sigmoidf_(bfhi(ow.y));
                    u32x2 w; w.x = cvt_pk_bf16(y0, y1); w.y = cvt_pk_bf16(y2, y3);
                    *(GAS u32x2*)(Yb8 + ((row0 + j) * OUTK + h * 256 + 32 * wave + 16 * vt + 4 * g) * 2u) = w;
                }
            }
        }
        }
        const float decay = fast_exp(m_st - pm_last);
#pragma unroll
        for (int mt = 0; mt < 8; ++mt)
#pragma unroll
            for (int vt = 0; vt < 2; ++vt) st[mt][vt] *= decay;
#pragma unroll
        for (int ks = 0; ks < 2; ++ks) {
            const bf16x8 vb0 = ldstr8(Vs, LDV_A, 32 * ks + 8 * g, 32 * wave, c, 4), vb1 = ldstr8(Vs, LDV_A, 32 * ks + 8 * g, 32 * wave + 16, c, 4);
#pragma unroll
            for (int mt = 0; mt < 8; ++mt) {
                const bf16x8 ka = ldstr8(Kw, LDQ_A, 32 * ks + 8 * g, 16 * mt, c, 4);
                st[mt][0] = mfma16(ka, vb0, st[mt][0]); st[mt][1] = mfma16(ka, vb1, st[mt][1]);
            }
        }
        {
            const int d = tid & 127, part = tid >> 7; float s = 0.f;
#pragma unroll
            for (int e = 0; e < 16; ++e) s += bf2f(Kw[(16 * part + e) * LDQ_A + d]);
            NVP[part * 128 + d] = s;
        }
    }
    if constexpr (MODE == 1) {
        __syncthreads();
        float* sl = SB + (size_t)((b * 4 + h) * 3 + grp) * ML_SLOT;
        if (tid < 128) {
            const float dlast = fast_exp(MST_[ck1 - 1] - PM_[64 * ck1 - 1]);
            sl[256 * 128 + tid] = dlast * NV[tid] + ((NVP[tid] + NVP[128 + tid]) + (NVP[256 + tid] + NVP[384 + tid]));
        }
        lane = tid & 63; g = lane >> 4; c = lane & 15;
#pragma unroll
        for (int mt = 0; mt < 8; ++mt)
#pragma unroll
            for (int vt = 0; vt < 2; ++vt) *(f32x4*)(sl + (32 * wave + 16 * vt + c) * 128 + 16 * mt + 4 * g) = st[mt][vt];
    }
}

__device__ __forceinline__ void gates_phase(const int tid, const bf16_t* xb, const bf16_t* WG, const float* rss, const float* gate_b, float* gates, const int gw, const int NGW) {
    const int lane = tid & 63, g = lane >> 4, c = lane & 15;
#pragma unroll 1
    for (int t = gw; t < MTOK / 16; t += NGW) {
        const int row = 16 * t + c;
        const GAS char* xrow = (const GAS char*)xb + ((unsigned)row * DM + 8u * g) * 2u;
        const GAS char* wrow = (const GAS char*)WG + ((unsigned)c * DM + 8u * g) * 2u;
        f32x4 acc = {0.f, 0.f, 0.f, 0.f};
#pragma unroll 1
        for (int s8 = 0; s8 < 4; ++s8) {
            bf16x8 xf[8], wf[8];
#pragma unroll
            for (int q = 0; q < 8; ++q) { xf[q] = *(const GAS bf16x8*)(xrow + (unsigned)(32 * (8 * s8 + q)) * 2u); wf[q] = *(const GAS bf16x8*)(wrow + (unsigned)(32 * (8 * s8 + q)) * 2u); }
#pragma unroll
            for (int q = 0; q < 8; ++q) acc = mfma16(wf[q], xf[q], acc);
        }
        const GAS f32x4* rp = (const GAS f32x4*)((const GAS char*)rss + (unsigned)row * 64u);
        const f32x4 tt = (rp[0] + rp[1]) + (rp[2] + rp[3]);
        const float rs = __builtin_amdgcn_rsqf(((tt[0] + tt[1]) + (tt[2] + tt[3])) * (1.0f / 1024.0f) + EPS);
        if (g < 2) {
            const f32x4 bb = *(const f32x4*)(gate_b + 4 * g);
            f32x4 o;
#pragma unroll
            for (int r = 0; r < 4; ++r) { const float x = acc[r] * rs + bb[r]; o[r] = (g == 0) ? x : (fminf(x, 0.f) - 0.693147180559945f * __builtin_amdgcn_logf(1.0f + fast_exp(-fabsf(x)))); }
            *(f32x4*)(gates + (size_t)row * 8 + 4 * g) = o;
        }
    }
}

#define XB_TMO      128
#define XB_XCNT(j)  (256  + 64 * (j))
#define XB_XSUB(j)  (1280 + 64 * (j))
#define XB_XGEN(j)  (2304 + 64 * (j))
#define XB_TOP      3328
#define XB_TOPGEN   3392
#define XB_SPIN_CAP (1u << 22)
__device__ __forceinline__ unsigned xb_ld(unsigned* p)              { return __hip_atomic_load(p, __ATOMIC_RELAXED, __HIP_MEMORY_SCOPE_AGENT); }
__device__ __forceinline__ unsigned xb_add(unsigned* p, unsigned v) { return __hip_atomic_fetch_add(p, v, __ATOMIC_RELAXED, __HIP_MEMORY_SCOPE_AGENT); }
__device__ __forceinline__ unsigned xb_xcc_id() { return (unsigned)__builtin_amdgcn_s_getreg((3 << 11) | 20) & 0xFu; }
#define XB_SPIN(cond, bar) do { unsigned _sp = 0; while (cond) { __builtin_amdgcn_s_sleep(1); \
    if ((++_sp & 255u) == 0u) { if (xb_ld(&(bar)[XB_TMO])) break; if (_sp > XB_SPIN_CAP) { atomicAdd(&(bar)[XB_TMO], 1u); break; } } } } while (0)
__device__ __forceinline__ void xcd_barrier_complete(unsigned* bar, unsigned x, unsigned& nloc, unsigned& nx) {
    const unsigned G = gridDim.x;
    unsigned sum, cnt, mine, sp = 0u;
    for (;;) {
        sum = 0u; cnt = 0u; mine = 0u;
#pragma unroll
        for (unsigned j = 0; j < 16; ++j) { const unsigned c = xb_ld(&bar[XB_XCNT(j)]); sum += c; cnt += (c > 0u) ? 1u : 0u; mine = (j == x) ? c : mine; }
        if (sum == G) break;
        __builtin_amdgcn_s_sleep(1);
        if ((++sp & 255u) == 0u) { if (xb_ld(&bar[XB_TMO])) break; if (sp > XB_SPIN_CAP) { atomicAdd(&bar[XB_TMO], 1u); break; } }
    }
    nloc = mine > 0u ? mine : 1u; nx = cnt > 0u ? cnt : 1u;
}
__device__ __forceinline__ void xcd_barrier(const int tid, unsigned* bar, volatile LAS unsigned* st) {
    asm volatile("s_waitcnt vmcnt(0)" ::: "memory");
    __syncthreads();
    if (tid == 0) {
        const unsigned x = xb_xcc_id();
        __builtin_amdgcn_s_waitcnt(0);
        unsigned nloc = st[0], nx = st[1];
        if (nloc == 0u) { xcd_barrier_complete(bar, x, nloc, nx); st[0] = nloc; st[1] = nx; }
        const unsigned old = xb_add(&bar[XB_XSUB(x)], 1u);
        const unsigned gen = old / nloc;
        if (old + 1u == (gen + 1u) * nloc) {
            __builtin_amdgcn_fence(__ATOMIC_RELEASE, "agent");
            asm volatile("s_waitcnt vmcnt(0)" ::: "memory");
            const unsigned og = xb_add(&bar[XB_TOP], 1u);
            const unsigned tg = og / nx;
            if (og + 1u == (tg + 1u) * nx) xb_add(&bar[XB_TOPGEN], 1u);
            else XB_SPIN(xb_ld(&bar[XB_TOPGEN]) == tg, bar);
            __builtin_amdgcn_fence(__ATOMIC_ACQUIRE, "agent");
            xb_add(&bar[XB_XGEN(x)], 1u);
            asm volatile("s_waitcnt vmcnt(0)" ::: "memory");
        } else {
            XB_SPIN(xb_ld(&bar[XB_XGEN(x)]) == gen, bar);
            __builtin_amdgcn_fence(__ATOMIC_ACQUIRE, "agent");
            asm volatile("s_waitcnt vmcnt(0)" ::: "memory");
        }
    }
    __syncthreads();
}

__global__ void __launch_bounds__(NTHREADS, 2) mega(Params p) {
    extern __shared__ __attribute__((aligned(16))) unsigned char smem[];
    LAS unsigned char* lds = (LAS unsigned char*)smem;
    const int G = gridDim.x, bid = blockIdx.x;
    const int wave_id = __builtin_amdgcn_readfirstlane((int)(threadIdx.x >> 6));
    volatile LAS unsigned* bst = (volatile LAS unsigned*)(lds + LDS_BYTES - 16);
    if (threadIdx.x == 0) {
#pragma unroll
        for (int k2 = 0; k2 < 23; ++k2) { const unsigned long long a = (unsigned long long)p.in[k2]; u32x2 w; w.x = (unsigned)a; w.y = (unsigned)(a >> 32); *(LAS u32x2*)(lds + LDS_PTRS + 8 * k2) = w; }
    }
    if (threadIdx.x == 0) { bst[0] = 0u; bst[1] = 0u; (void)xb_add(&((unsigned*)(p.ws + WS_BAR))[XB_XCNT(xb_xcc_id())], 1u); }
    __syncthreads();
#pragma unroll 1
    for (int s = p.ph_lo; s < p.ph_hi; ++s) {
#define FRESH_TID(v) do { asm volatile("v_mbcnt_lo_u32_b32 %0, -1, 0\n\tv_mbcnt_hi_u32_b32 %0, -1, %0" : "=v"(v)); v += wave_id * 64; } while (0)
        int tid; FRESH_TID(tid);
        unsigned char* ws = p.ws; asm volatile("" : "+s"(ws));
        if (p.ph_lo < 0) cg::this_grid().sync();
        if (s > p.ph_lo) xcd_barrier(tid, (unsigned*)(ws + WS_BAR), bst);
        bf16_t* xb = (bf16_t*)(ws + WS_XB); bf16_t* Hb = (bf16_t*)(ws + WS_H); bf16_t* Yb = (bf16_t*)p.out; unsigned char* xlo = ws + WS_Y;
        float* rss = (float*)(ws + WS_RSS); float* gates = (float*)(ws + WS_GATES);
        const int L = (s == 0) ? 0 : (s - 1) / 7, k = (s == 0) ? 0 : (s - 1) % 7 + 1, j = L >> 1; const bool isA = (L & 1) == 0;
        unsigned char* wsl = ws + ((L & 1) ? WS_SET1 : (size_t)0);
        if (k == 0) {
            FRESH_TID(tid);
            convert_phase(tid, p, ws, 0, lds, bid * 8 + (tid >> 6), G * 8, true);
        } else if (k == 1 || k == 6) {
            FRESH_TID(tid);
            if (L == 0 && k == 1) {
                pg8::Gemm g{(const bf16_t*)(ws + WS_MEMB), (const bf16_t*)(ws + WS_MEMW), MROWS, 1024, DM}; pg8::StaticOrder S; S.init(MROWS, 1024, G, bid);
                pg8::EpiMemKV E{(const float*)(ws + WS_MEMRS), (bf16_t*)(ws + WS_MEMK), (bf16_t*)(ws + WS_MEMVT), nullptr};
                pg8::gemm_phase<pg8::EpiMemKV>(tid, lds, g, S, E);
            }
            FRESH_TID(tid);
            pg8::Gemm g{xb, (const bf16_t*)(wsl + (k == 1 ? WS_WIN0 : WS_WIN1)), MTOK, 2 * DFF, DM}; pg8::StaticOrder S; S.init(MTOK, 2 * DFF, G, bid);
            pg8::EpiSwiglu E{rss, Hb};
            pg8::gemm_phase<pg8::EpiSwiglu>(tid, lds, g, S, E);

        } else if (k == 2 || k == 5 || k == 7) {
            FRESH_TID(tid);
            const bf16_t* A = (k == 5) ? Yb : Hb; const int K = (k == 5) ? OUTK : DFF;
            const bf16_t* W = (const bf16_t*)(wsl + (k == 2 ? WS_WOUT0 : (k == 5 ? WS_MOUT : WS_WOUT1)));
            pg8::Gemm g{A, W, MTOK, DM, K}; pg8::StaticOrder S; S.init(MTOK, DM, G, bid);
            pg8::EpiResid E{(L == DEPTH - 1 && k == 7) ? p.out : nullptr, xb, xlo, rss};
            pg8::gemm_phase<pg8::EpiResid>(tid, lds, g, S, E);
        } else if (k == 3) {
            FRESH_TID(tid);
            const int N = isA ? A_LDP : B_INW;
            pg8::Gemm g{xb, (const bf16_t*)(wsl + WS_MIN), MTOK, N, DM}; pg8::StaticOrder S; S.init(MTOK, N, G, bid);
            pg8::EpiProj E{rss, Hb, N};
            pg8::gemm_phase<pg8::EpiProj>(tid, lds, g, S, E);
            if (isA) { FRESH_TID(tid); gates_phase(tid, xb, (const bf16_t*)(wsl + WS_WG), rss, INP(15) + j * 8, gates, bid * 8 + (tid >> 6), G * 8); }
        } else {
            FRESH_TID(tid);
            if (isA) {
                for (int it = bid; it < 192; it += G) { FRESH_TID(tid); mlstm_item<1>(tid, p, ws, j, it / 3, it % 3, Hb, Yb, lds); }
                FRESH_TID(tid);
                for (int it = bid; it < 512; it += G) mem_attn_item(tid, p, ws, L, it, Hb, A_LDP, 3072, Yb, lds);
                if (L + 1 < DEPTH) { __syncthreads(); convert_phase(tid, p, ws, L + 1, lds, bid * 8 + (tid >> 6), G * 8, false); }
                xcd_barrier(tid, (unsigned*)(ws + WS_BAR), bst);
                FRESH_TID(tid);
                for (int it = bid; it < 256; it += G) { FRESH_TID(tid); mlstm_item<2>(tid, p, ws, j, it >> 2, it & 3, Hb, Yb, lds); }
            } else {
                for (int it = bid; it < 512; it += G) swa_item(tid, p, ws, j, it, Hb, Yb, lds);
                for (int it = bid; it < 512; it += G) mem_attn_item(tid, p, ws, L, it, Hb, B_INW, 1280, Yb, lds);
                if (L + 1 < DEPTH) { __syncthreads(); convert_phase(tid, p, ws, L + 1, lds, bid * 8 + (tid >> 6), G * 8, false); }
            }
        }
    }
}

extern "C" void kernel_launch(void* const* d_in, const int* in_sizes, int n_in, void* d_out, int out_size, void* d_ws, size_t ws_size, hipStream_t stream) {
    static int grid = 0;
    if (grid == 0) {
        int dev = 0, cus = 0, per_cu = 0;
        hipGetDevice(&dev);
        hipDeviceGetAttribute(&cus, hipDeviceAttributeMultiprocessorCount, dev);
        if (hipFuncSetAttribute((const void*)mega, hipFuncAttributeMaxDynamicSharedMemorySize, LDS_BYTES) != hipSuccess) { fprintf(stderr, "kernel_launch: hipFuncSetAttribute failed\n"); grid = -1; return; }
        hipOccupancyMaxActiveBlocksPerMultiprocessor(&per_cu, (const void*)mega, NTHREADS, LDS_BYTES);
        if (per_cu < 1) { fprintf(stderr, "kernel_launch: occupancy query says %d blocks per CU\n", per_cu); per_cu = 1; }
        (void)hipGetLastError();
        grid = cus * 1;
        if (n_in != 23 || ws_size < WS_END) { fprintf(stderr, "kernel_launch: unexpected n_in %d / ws %zu (need %zu)\n", n_in, ws_size, (size_t)WS_END); grid = -1; return; }
    }
    if (grid < 0) return;
    Params p{};
    for (int i = 0; i < 23; ++i) p.in[i] = (const float*)d_in[i];
    p.out = (float*)d_out; p.ws = (unsigned char*)d_ws;
    p.ph_lo = 0; p.ph_hi = 1 + 7 * DEPTH;
    if (hipMemsetAsync((char*)d_ws + WS_BAR, 0, (size_t)XCD_BAR_WORDS_C * 4, stream) != hipSuccess) { fprintf(stderr, "kernel_launch: memset of barrier words failed\n"); return; }
    void* args[] = {&p};
    hipError_t e = hipLaunchCooperativeKernel((const void*)mega, dim3(grid), dim3(NTHREADS), args, LDS_BYTES, stream);
    if (e != hipSuccess) fprintf(stderr, "cooperative launch failed: %s (grid %d)\n", hipGetErrorString(e), grid);
}
```
